# Optimizing an MI355X kernel written in HIP

```python
import math
import jax
import jax.numpy as jnp
from jax import lax
import numpy as np

D_MODEL = 1024
BATCH = 2
SEQ = 8192
DEPTH = 1
DEC_BATCH = 16
DEC_SEQ = 16
PAST_LEN = 2048

CHUNK = 64
N_META = 16
Q_BLOCK = 128
RWKV_HEAD_DIM = 64
RWKV_WIDTH = D_MODEL // 2
RWKV_HEADS = RWKV_WIDTH // RWKV_HEAD_DIM
DECAY_LORA = 64
AAA_LORA = 64
GATE_LORA = 128
DECAY_SCALE = 0.6065306597126334
V_HEAD = 64
MLA_WIDTH = D_MODEL - RWKV_WIDTH
MLA_HEADS = MLA_WIDTH // V_HEAD
Q_LORA = 384
KV_LORA = 256
QK_NOPE = 64
QK_ROPE = 32
ATTN_SCALE = (QK_NOPE + QK_ROPE) ** -0.5
ROPE_THETA = 10000.0
MIX_WIDTH = RWKV_WIDTH + MLA_WIDTH
C_RWKV = 3 * RWKV_WIDTH + DECAY_LORA + AAA_LORA + GATE_LORA
C_MLA = Q_LORA + KV_LORA + QK_ROPE
C_IN = C_RWKV + C_MLA
D_FF = 4 * D_MODEL
LN_EPS = 1e-5
RMS_EPS = 1e-6
GN_EPS = 64e-5
DEEPNORM_ALPHA = (2.0 * DEPTH) ** 0.25
DEEPNORM_BETA = (8.0 * DEPTH) ** -0.25
NEG_INF = -1e30

kernel_name = 'hymba_rwkv7_mla_streaming_encoder_step'


def _layernorm(x, g, b):
    xf = x.astype(jnp.float32)
    mu = jnp.mean(xf, -1, keepdims=True)
    var = jnp.mean(jnp.square(xf - mu), -1, keepdims=True)
    return ((xf - mu) * lax.rsqrt(var + LN_EPS) * g + b).astype(x.dtype)


def _rmsnorm(x, g):
    xf = x.astype(jnp.float32)
    return (xf * lax.rsqrt(jnp.mean(xf * xf, -1, keepdims=True) + RMS_EPS) * g).astype(x.dtype)


def _rope_tables(pos):
    inv = ROPE_THETA ** (-jnp.arange(0, QK_ROPE, 2, dtype=jnp.float32) / QK_ROPE)
    ang = pos.astype(jnp.float32)[:, None] * inv[None, :]
    return jnp.cos(ang), jnp.sin(ang)


def _rope(x, cos, sin):
    half = QK_ROPE // 2
    x1, x2 = x[..., :half], x[..., half:]
    return jnp.concatenate([x1 * cos - x2 * sin, x1 * sin + x2 * cos], axis=-1).astype(x.dtype)


def _project(xn, shift_prev, w_in, mu_shift):
    p = jnp.einsum('bld,dc->blc', xn, w_in)
    pr, pm = p[..., :C_RWKV], p[..., C_RWKV:]
    prev = jnp.concatenate([shift_prev.astype(pr.dtype), pr[:, :-1]], axis=1)
    return pr + mu_shift * (prev - pr), pm, pr[:, -1:]


def _rwkv7(pr_s, s0, w_decay_up, decay_base, w_aaa_up, aaa_base, w_gate_up, k_k, k_a, r_k, gn_g, gn_b):
    f32 = jnp.float32
    p = pr_s.astype(f32)
    b, l, _ = p.shape
    W = RWKV_WIDTH
    o_ad = 3 * W + DECAY_LORA
    o_gd = o_ad + AAA_LORA
    r, k, v = p[..., :W], p[..., W:2 * W], p[..., 2 * W:3 * W]
    wd, ad, gd = p[..., 3 * W:o_ad], p[..., o_ad:o_gd], p[..., o_gd:]
    w = jnp.exp(-DECAY_SCALE * jax.nn.sigmoid(decay_base + jnp.tanh(wd) @ w_decay_up))
    a = jax.nn.sigmoid(aaa_base + ad @ w_aaa_up)
    g = jax.nn.sigmoid(gd) @ w_gate_up
    heads = lambda t: t.reshape(b, l, RWKV_HEADS, RWKV_HEAD_DIM)
    kk = heads(k * k_k)
    kk = kk / jnp.maximum(jnp.sqrt(jnp.sum(kk * kk, -1, keepdims=True)), 1e-12)
    kt = k * (1.0 + (a - 1.0) * k_a)
    tm = lambda t: jnp.moveaxis(t, 1, 0)
    xs = (tm(heads(r)), tm(heads(w)), tm(heads(kt)), tm(heads(v)), tm(kk), tm(heads(a)))

    def step(S, inp):
        r_t, w_t, k_t, v_t, kk_t, a_t = inp
        sa = jnp.einsum('bhij,bhj->bhi', S, -kk_t)
        S = S * w_t[..., None, :] + sa[..., :, None] * (kk_t * a_t)[..., None, :] + v_t[..., :, None] * k_t[..., None, :]
        return S, jnp.einsum('bhij,bhj->bhi', S, r_t)

    S, ys = lax.scan(step, s0.astype(f32), xs)
    y = jnp.moveaxis(ys, 0, 1)
    mu = jnp.mean(y, -1, keepdims=True)
    var = jnp.mean(jnp.square(y - mu), -1, keepdims=True)
    yn = ((y - mu) * lax.rsqrt(var + GN_EPS)).reshape(b, l, W) * gn_g + gn_b
    bonus = (jnp.sum(heads(r * kt * r_k), -1, keepdims=True) * heads(v)).reshape(b, l, W)
    return ((yn + bonus) * g).astype(pr_s.dtype), S


def _mla_q(pm, q_norm_g, w_qb, cos, sin):
    b, l, _ = pm.shape
    q = jnp.einsum('blr,rc->blc', _rmsnorm(pm[..., :Q_LORA], q_norm_g), w_qb)
    q = q.reshape(b, l, MLA_HEADS, QK_NOPE + QK_ROPE)
    return q[..., :QK_NOPE], _rope(q[..., QK_NOPE:], cos[None, :, None], sin[None, :, None])


def _mla_latent(pm, kv_norm_g, cos, sin):
    c = _rmsnorm(pm[..., Q_LORA:Q_LORA + KV_LORA], kv_norm_g)
    kr = _rope(pm[..., Q_LORA + KV_LORA:], cos[None], sin[None])
    return c, kr


def _mla_expand(c, w_kvb):
    b, l, _ = c.shape
    kv = jnp.einsum('blr,rc->blc', c, w_kvb).reshape(b, l, MLA_HEADS, QK_NOPE + V_HEAD)
    return kv[..., :QK_NOPE], kv[..., QK_NOPE:]


def _mla_attend(q_nope, q_rope, k_nope, k_rope, v, mask):
    s = jnp.einsum('bqhd,bkhd->bhqk', q_nope, k_nope) + jnp.einsum('bqhr,bkr->bhqk', q_rope, k_rope)
    s = s.astype(jnp.float32) * ATTN_SCALE
    if mask is not None:
        s = jnp.where(mask, s, NEG_INF)
    p = jax.nn.softmax(s, axis=-1).astype(v.dtype)
    return jnp.einsum('bhqk,bkhd->bqhd', p, v)


def _mla_prompt_attention(qn, qr, kn, kr, v, cid):
    b, l = qn.shape[0], qn.shape[1]
    seq = l - N_META
    meta_o = _mla_attend(qn[:, :N_META], qr[:, :N_META], kn[:, :N_META], kr[:, :N_META], v[:, :N_META], None)
    n_blk = seq // Q_BLOCK
    blocks = lambda t: jnp.moveaxis(t[:, N_META:].reshape((b, n_blk, Q_BLOCK) + t.shape[2:]), 1, 0)
    cq = cid[N_META:].reshape(n_blk, Q_BLOCK)

    def one_block(args):
        qn_i, qr_i, cq_i = args
        mask = cid[None, :] <= cq_i[:, None]
        return _mla_attend(qn_i, qr_i, kn, kr, v, mask)

    o = lax.map(one_block, (blocks(qn), blocks(qr), cq))
    o = jnp.moveaxis(o, 0, 1).reshape(b, seq, MLA_HEADS, V_HEAD)
    return jnp.concatenate([meta_o, o], axis=1)


def _merge(o_rw, o_at, mla_out_g, w_out):
    b, l = o_rw.shape[0], o_rw.shape[1]
    o_at = _rmsnorm(o_at.reshape(b, l, MLA_WIDTH), mla_out_g).astype(o_rw.dtype)
    return jnp.einsum('blc,cd->bld', jnp.concatenate([o_rw, o_at], axis=-1), w_out)


def _post(x, mix, ln1_g, ln1_b, w_up, w_down, ln2_g, ln2_b):
    h = _layernorm(DEEPNORM_ALPHA * x + mix, ln1_g, ln1_b)
    f = jnp.einsum('blf,fd->bld', jnp.square(jax.nn.relu(jnp.einsum('bld,df->blf', h, w_up))), w_down)
    return _layernorm(DEEPNORM_ALPHA * h + f, ln2_g, ln2_b)


def setup_inputs(seed: int = 0) -> dict:
    key = jax.random.key(seed)
    keys = jax.random.split(key, 40)

    def nrm(i, shape, scale=1.0):
        return scale * jax.random.normal(keys[i], shape, jnp.float32)

    Dp = DEPTH
    return {
        'x_prompt': nrm(0, (BATCH, SEQ, D_MODEL)),
        'x_sample': nrm(1, (DEC_BATCH, DEC_SEQ, D_MODEL)),
        'cache_mla_latent': nrm(2, (Dp, DEC_BATCH, PAST_LEN, KV_LORA)),
        'cache_mla_rope': nrm(3, (Dp, DEC_BATCH, PAST_LEN, QK_ROPE)),
        'state_rwkv': nrm(4, (Dp, DEC_BATCH, RWKV_HEADS, RWKV_HEAD_DIM, RWKV_HEAD_DIM), 0.1),
        'state_shift': nrm(5, (Dp, DEC_BATCH, 1, C_RWKV)),
        'meta_tokens': nrm(6, (N_META, D_MODEL)),
        'ln_in_g': 1.0 + nrm(7, (D_MODEL,), 0.05),
        'ln_in_b': nrm(8, (D_MODEL,), 0.02),
        'w_in': nrm(9, (Dp, D_MODEL, C_IN), D_MODEL ** -0.5),
        'mu_shift': jax.random.uniform(keys[10], (Dp, C_RWKV), jnp.float32),
        'w_decay_up': nrm(11, (Dp, DECAY_LORA, RWKV_WIDTH), DECAY_LORA ** -0.5),
        'decay_base': nrm(12, (Dp, RWKV_WIDTH), 0.5),
        'w_aaa_up': nrm(13, (Dp, AAA_LORA, RWKV_WIDTH), AAA_LORA ** -0.5),
        'aaa_base': nrm(14, (Dp, RWKV_WIDTH), 0.5),
        'w_gate_up': nrm(15, (Dp, GATE_LORA, RWKV_WIDTH), GATE_LORA ** -0.5),
        'k_k': 0.85 + nrm(16, (Dp, RWKV_WIDTH), 0.1),
        'k_a': 1.0 + nrm(17, (Dp, RWKV_WIDTH), 0.1),
        'r_k': nrm(18, (Dp, RWKV_WIDTH), 0.1),
        'gn_g': 1.0 + nrm(19, (Dp, RWKV_WIDTH), 0.05),
        'gn_b': nrm(20, (Dp, RWKV_WIDTH), 0.02),
        'q_norm_g': 1.0 + nrm(21, (Dp, Q_LORA), 0.05),
        'w_qb': nrm(22, (Dp, Q_LORA, MLA_HEADS * (QK_NOPE + QK_ROPE)), Q_LORA ** -0.5),
        'kv_norm_g': 1.0 + nrm(23, (Dp, KV_LORA), 0.05),
        'w_kvb': nrm(24, (Dp, KV_LORA, MLA_HEADS * (QK_NOPE + V_HEAD)), KV_LORA ** -0.5),
        'mla_out_g': 1.0 + nrm(25, (Dp, MLA_WIDTH), 0.05),
        'w_out': nrm(26, (Dp, MIX_WIDTH, D_MODEL), DEEPNORM_BETA * MIX_WIDTH ** -0.5),
        'ln1_g': 1.0 + nrm(27, (Dp, D_MODEL), 0.05),
        'ln1_b': nrm(28, (Dp, D_MODEL), 0.02),
        'w_up': nrm(29, (Dp, D_MODEL, D_FF), D_MODEL ** -0.5),
        'w_down': nrm(30, (Dp, D_FF, D_MODEL), DEEPNORM_BETA * D_FF ** -0.5),
        'ln2_g': 1.0 + nrm(31, (Dp, D_MODEL), 0.05),
        'ln2_b': nrm(32, (Dp, D_MODEL), 0.02),
    }


def reference(x_prompt, x_sample, cache_mla_latent, cache_mla_rope, state_rwkv, state_shift,
              meta_tokens, ln_in_g, ln_in_b, w_in, mu_shift, w_decay_up, decay_base, w_aaa_up,
              aaa_base, w_gate_up, k_k, k_a, r_k, gn_g, gn_b, q_norm_g, w_qb, kv_norm_g, w_kvb,
              mla_out_g, w_out, ln1_g, ln1_b, w_up, w_down, ln2_g, ln2_b):
    b_p, seq = x_prompt.shape[0], x_prompt.shape[1]
    b_s, dec_seq = x_sample.shape[0], x_sample.shape[1]
    meta = jnp.broadcast_to(meta_tokens.astype(x_prompt.dtype)[None], (b_p, N_META, D_MODEL))
    hp = _layernorm(jnp.concatenate([meta, x_prompt], axis=1), ln_in_g, ln_in_b)
    hs = _layernorm(x_sample, ln_in_g, ln_in_b)
    cos_p, sin_p = _rope_tables(jnp.arange(N_META + seq))
    cos_s, sin_s = _rope_tables(PAST_LEN + jnp.arange(dec_seq))
    cid_p = jnp.concatenate([jnp.full((N_META,), -1, jnp.int32), jnp.arange(seq, dtype=jnp.int32) // CHUNK])
    lat_p, rope_p, wkv_p, shift_p = [], [], [], []
    lat_s, rope_s, wkv_s, shift_s = [], [], [], []
    for l in range(DEPTH):
        rw = (w_decay_up[l], decay_base[l], w_aaa_up[l], aaa_base[l], w_gate_up[l],
              k_k[l], k_a[l], r_k[l], gn_g[l], gn_b[l])
        post = (ln1_g[l], ln1_b[l], w_up[l], w_down[l], ln2_g[l], ln2_b[l])
        pr, pm, last = _project(hp, jnp.zeros((b_p, 1, C_RWKV), hp.dtype), w_in[l], mu_shift[l])
        o_rw, s_fin = _rwkv7(pr, jnp.zeros((b_p, RWKV_HEADS, RWKV_HEAD_DIM, RWKV_HEAD_DIM), jnp.float32), *rw)
        qn, qr = _mla_q(pm, q_norm_g[l], w_qb[l], cos_p, sin_p)
        c_p, kr_p = _mla_latent(pm, kv_norm_g[l], cos_p, sin_p)
        kn, vv = _mla_expand(c_p, w_kvb[l])
        o_at = _mla_prompt_attention(qn, qr, kn, kr_p, vv, cid_p)
        hp = _post(hp, _merge(o_rw, o_at, mla_out_g[l], w_out[l]), *post)
        lat_p.append(c_p)
        rope_p.append(kr_p)
        wkv_p.append(s_fin.astype(x_prompt.dtype))
        shift_p.append(last)
        pr, pm, last = _project(hs, state_shift[l], w_in[l], mu_shift[l])
        o_rw, s_fin = _rwkv7(pr, state_rwkv[l], *rw)
        qn, qr = _mla_q(pm, q_norm_g[l], w_qb[l], cos_s, sin_s)
        c_s, kr_s = _mla_latent(pm, kv_norm_g[l], cos_s, sin_s)
        c_all = jnp.concatenate([cache_mla_latent[l].astype(c_s.dtype), c_s], axis=1)
        kr_all = jnp.concatenate([cache_mla_rope[l].astype(kr_s.dtype), kr_s], axis=1)
        kn, vv = _mla_expand(c_all, w_kvb[l])
        o_at = _mla_attend(qn, qr, kn, kr_all, vv, None)
        hs = _post(hs, _merge(o_rw, o_at, mla_out_g[l], w_out[l]), *post)
        lat_s.append(c_s)
        rope_s.append(kr_s)
        wkv_s.append(s_fin.astype(state_rwkv.dtype))
        shift_s.append(last)
    y_prompt = hp[:, N_META:]
    y_sample = hs
    return (y_prompt, y_sample,
            jnp.stack(lat_p), jnp.stack(rope_p), jnp.stack(wkv_p), jnp.stack(shift_p),
            jnp.stack(lat_s), jnp.stack(rope_s), jnp.stack(wkv_s), jnp.stack(shift_s))
```

```cpp
#include <hip/hip_runtime.h>
#include <hip/hip_cooperative_groups.h>
#include <cstdio>
namespace cg = cooperative_groups;

typedef unsigned short u16;
typedef __attribute__((ext_vector_type(8))) short bf16x8;
typedef __attribute__((ext_vector_type(16))) float f32x16;
typedef __attribute__((ext_vector_type(2))) float f32x2;
typedef __attribute__((ext_vector_type(4))) unsigned u32x4;
typedef __attribute__((ext_vector_type(2))) unsigned u32x2;
typedef __attribute__((ext_vector_type(2))) __bf16 bf16x2_t;

#define DI __device__ __forceinline__
#define MFMA32(a, b, c) __builtin_amdgcn_mfma_f32_32x32x16_bf16((a), (b), (c), 0, 0, 0)

constexpr int D_ = 1024;
constexpr int LP = 8208;
constexpr int TP = 16416;
constexpr int TS = 256;
constexpr int MT = TP + TS;
constexpr int M2 = 16640;
constexpr int LKS = 2064;
constexpr int TKS = 16 * LKS;
constexpr int CR = 1792;
constexpr int CIN = 2464;
constexpr int NRKV = 1536;
constexpr int NREST = 928;
constexpr int LDVP = TP + 64;
constexpr int LDVS = TKS + 64;

constexpr size_t OFF_WIN = 0;
constexpr size_t OFF_WQB = OFF_WIN + (size_t)CIN * 1024 * 2;
constexpr size_t OFF_WKN = OFF_WQB + (size_t)768 * 384 * 2;
constexpr size_t OFF_WV = OFF_WKN + (size_t)512 * 256 * 2;
constexpr size_t OFF_WDEC = OFF_WV + (size_t)512 * 256 * 2;
constexpr size_t OFF_WAAA = OFF_WDEC + (size_t)512 * 64 * 2;
constexpr size_t OFF_WGATE = OFF_WAAA + (size_t)512 * 64 * 2;
constexpr size_t OFF_WOUT = OFF_WGATE + (size_t)512 * 128 * 2;
constexpr size_t OFF_WUP = OFF_WOUT + (size_t)1024 * 1024 * 2;
constexpr size_t OFF_WDOWN = OFF_WUP + (size_t)4096 * 1024 * 2;
constexpr size_t OFF_PRKV = OFF_WDOWN + (size_t)4096 * 1024 * 2;
constexpr size_t OFF_R2 = OFF_PRKV + (size_t)MT * NRKV * 2;
constexpr size_t OFF_GG = OFF_R2 + (size_t)MT * 1024 * 2;
constexpr size_t OFF_Q = OFF_GG + (size_t)MT * 512 * 2;
constexpr size_t OFF_KNP = OFF_Q + (size_t)MT * 768 * 2;
constexpr size_t OFF_VTP = OFF_KNP + (size_t)(TP + 64) * 512 * 2;
constexpr size_t OFF_R6 = OFF_VTP + (size_t)512 * LDVP * 2;
constexpr size_t OFF_VTS = OFF_R6 + (size_t)(TKS + 64) * 512 * 2;
constexpr size_t OFF_KRP = OFF_VTS + (size_t)512 * LDVS * 2;
constexpr size_t OFF_KRS = OFF_KRP + (size_t)(TP + 64) * 32 * 2;
constexpr size_t OFF_ROPE = OFF_KRS + (size_t)(TKS + 64) * 32 * 2;
constexpr size_t OFF_STATS = OFF_ROPE + (size_t)LP * 16 * 4 * 2;
constexpr size_t OFF_CNT = OFF_STATS + (size_t)MT * 2 * 4;
constexpr size_t OFF_PRE8 = OFF_CNT + 8192;
constexpr size_t OFF_XB = OFF_PRE8 + (size_t)MT * 8 * 4;
constexpr size_t WS_END = OFF_XB + 16384;
static_assert(WS_END < (size_t)256 * 1024 * 1024, "ws overflow");
constexpr size_t OFF_OCAT = OFF_R6;
constexpr size_t OFF_H1B = OFF_PRKV;
constexpr size_t OFF_ACT = OFF_R2;
static_assert(OFF_ACT + (size_t)M2 * 4096 * 2 < (size_t)256 * 1024 * 1024, "act overflow");
static_assert((size_t)M2 * 1024 * 2 <= (size_t)MT * NRKV * 2, "h1b overflow");

constexpr size_t SC_AA = 0;
constexpr size_t SC_LIN = SC_AA + (size_t)MT * 512 * 2;
constexpr size_t SC_QN = SC_LIN + (size_t)MT * 256 * 2;
constexpr size_t SC_CBP = SC_QN + (size_t)MT * 384 * 2;
constexpr size_t SC_CBS = SC_CBP + (size_t)TP * 256 * 2;
constexpr size_t SC_END = SC_CBS + (size_t)TKS * 256 * 2;
static_assert(SC_END <= (size_t)2 * 8192 * 1024 * 4, "scratch overflow");
constexpr size_t SC_YB = SC_LIN;
constexpr size_t SC_OAT = SC_CBP;
static_assert(SC_YB + (size_t)MT * 512 * 2 <= SC_CBP, "yb overflow");
static_assert(SC_OAT + (size_t)MT * 512 * 2 <= SC_END, "oat overflow");

constexpr size_t O_Y = 0;
constexpr size_t O_LATP = (size_t)M2 * 1024;
constexpr size_t O_ROPEP = O_LATP + (size_t)TP * 256;
constexpr size_t O_STATEP = O_ROPEP + (size_t)TP * 32;
constexpr size_t O_SHIFTP = O_STATEP + (size_t)2 * 8 * 64 * 64;
constexpr size_t O_LATS = O_SHIFTP + (size_t)2 * CR;
constexpr size_t O_ROPES = O_LATS + (size_t)TS * 256;
constexpr size_t O_STATES = O_ROPES + (size_t)TS * 32;
constexpr size_t O_SHIFTS = O_STATES + (size_t)16 * 8 * 64 * 64;

constexpr float ALPHA = 1.189207115002721f;
constexpr float DECAY_SCALE = 0.6065306597126334f;
constexpr float QSCALE = 0.10206207261596577f * 1.4426950408889634f;

constexpr int SMEM_BYTES = 81472 + 64;

struct Params {
  const float* in[33];
  float* out;
  char* ws;
};

DI u16 f2bf(float f) { unsigned u = __float_as_uint(f); u += 0x7FFFu + ((u >> 16) & 1u); return (u16)(u >> 16); }
DI float bf2f(u16 h) { return __uint_as_float(((unsigned)h) << 16); }
DI unsigned pack2(float a, float b) {
  f32x2 v = {a, b};
  bf16x2_t r = __builtin_convertvector(v, bf16x2_t);
  return __builtin_bit_cast(unsigned, r);
}
template <int CTRL> DI float dppf(float x) {
  return __int_as_float(__builtin_amdgcn_mov_dpp(__float_as_int(x), CTRL, 0xF, 0xF, true));
}
DI float allreduce16(float x) {
  x += dppf<0xB1>(x);
  x += dppf<0x4E>(x);
  x += dppf<0x141>(x);
  x += dppf<0x140>(x);
  return x;
}
DI float allreduce32(float x) {
  x = allreduce16(x);
  auto t = __builtin_amdgcn_permlane16_swap(__float_as_uint(x), __float_as_uint(x), false, false);
  return __uint_as_float(t[0]) + __uint_as_float(t[1]);
}
DI float wave_sum(float x) {
  x = allreduce32(x);
  auto t = __builtin_amdgcn_permlane32_swap(__float_as_uint(x), __float_as_uint(x), false, false);
  return __uint_as_float(t[0]) + __uint_as_float(t[1]);
}
DI float sigmoidf_(float x) { return 1.0f / (1.0f + __expf(-x)); }
DI float tanhf_(float x) { float e = __expf(2.0f * x); return 1.0f - 2.0f / (e + 1.0f); }

constexpr int GLD = 72;
constexpr int GBUF = 256 * GLD;
template <class Epi>
__device__ __forceinline__ void gemm_tile(const u16* __restrict__ A, int lda, const u16* __restrict__ Bt, int ldb,
                          int M, int N, int K, int m0, int n0, Epi& epi, u16* smem) {
  u16* As = smem;
  u16* Bs = smem + 128 * GLD;
  const int tid = threadIdx.x, lane = tid & 63, wave = tid >> 6;
  const int wm = wave >> 1, wn = wave & 1;
  const int r = lane & 31, hh = lane >> 5;
  size_t aoff[4], boff[4];
  int soff[4];
#pragma unroll
  for (int i = 0; i < 4; ++i) {
    int c = tid + 256 * i;
    int row = c >> 3, kc = c & 7;
    int ar = m0 + row; ar = ar < M ? ar : M - 1;
    int br = n0 + row; br = br < N ? br : N - 1;
    aoff[i] = (size_t)ar * lda + kc * 8;
    boff[i] = (size_t)br * ldb + kc * 8;
    soff[i] = row * GLD + kc * 8;
  }
  struct GRegs { u32x4 a[4], b[4]; };
  auto prefetch = [&](GRegs& R, int kt) {
#pragma unroll
    for (int i = 0; i < 4; ++i) {
      R.a[i] = *(const u32x4*)(A + aoff[i] + (size_t)kt * 64);
      R.b[i] = *(const u32x4*)(Bt + boff[i] + (size_t)kt * 64);
    }
  };
  auto lds_write = [&](const GRegs& R, int buf) {
#pragma unroll
    for (int i = 0; i < 4; ++i) {
      *(u32x4*)(As + buf * GBUF + soff[i]) = R.a[i];
      *(u32x4*)(Bs + buf * GBUF + soff[i]) = R.b[i];
    }
  };
  f32x16 acc[2][2];
#pragma unroll
  for (int i = 0; i < 2; ++i)
#pragma unroll
    for (int j = 0; j < 2; ++j)
#pragma unroll
      for (int e = 0; e < 16; ++e) acc[i][j][e] = 0.f;
  auto compute = [&](int buf) {
    const u16* Ab = As + buf * GBUF;
    const u16* Bb = Bs + buf * GBUF;
#pragma unroll
    for (int ks = 0; ks < 4; ++ks) {
      bf16x8 af[2], bfr[2];
#pragma unroll
      for (int i = 0; i < 2; ++i) {
        af[i] = *(const bf16x8*)(Ab + (wm * 64 + i * 32 + r) * GLD + ks * 16 + hh * 8);
        bfr[i] = *(const bf16x8*)(Bb + (wn * 64 + i * 32 + r) * GLD + ks * 16 + hh * 8);
      }
#pragma unroll
      for (int i = 0; i < 2; ++i)
#pragma unroll
        for (int j = 0; j < 2; ++j) acc[i][j] = MFMA32(af[i], bfr[j], acc[i][j]);
    }
  };
  const int nk = K >> 6;
  GRegs RA, RB;
  prefetch(RA, 0);
  if (1 < nk) prefetch(RB, 1);
  lds_write(RA, 0);
  __syncthreads();
  for (int kt = 0; kt < nk; kt += 2) {
    if (kt + 2 < nk) prefetch(RA, kt + 2);
    compute(0);
    if (kt + 1 < nk) lds_write(RB, 1);
    __syncthreads();
    if (kt + 1 < nk) {
      if (kt + 3 < nk) prefetch(RB, kt + 3);
      compute(1);
      if (kt + 2 < nk) lds_write(RA, 0);
      __syncthreads();
    }
  }
#pragma unroll
  for (int i = 0; i < 2; ++i)
#pragma unroll
    for (int j = 0; j < 2; ++j) {
      const int col = n0 + wn * 64 + j * 32 + r;
#pragma unroll
      for (int e = 0; e < 16; ++e) {
        const int row = m0 + wm * 64 + i * 32 + (e & 3) + 8 * (e >> 2) + 4 * hh;
        epi(row, col, acc[i][j][e], (row < M) && (col < N));
      }
    }
}

template <class Epi, class Map>
__device__ __forceinline__ void gemm_phase(const u16* __restrict__ A, int lda, const u16* __restrict__ Bt, int ldb,
                                           int M, int N, int K, int ntiles, Map tmap, Epi& epi, u16* smem) {
  u16* As = smem;
  u16* Bs = smem + 128 * GLD;
  const int tid = threadIdx.x, lane = tid & 63, wave = tid >> 6;
  const int wm = wave >> 1, wn = wave & 1;
  const int r = lane & 31, hh = lane >> 5;
  int t = blockIdx.x;
  if (t >= ntiles) return;
  size_t aoff[4], boff[4];
  int soff[4];
#pragma unroll
  for (int i = 0; i < 4; ++i) { int c = tid + 256 * i; soff[i] = (c >> 3) * GLD + (c & 7) * 8; }
  auto set_tile = [&](int m0, int n0) {
#pragma unroll
    for (int i = 0; i < 4; ++i) {
      int c = tid + 256 * i;
      int row = c >> 3, kc = c & 7;
      int ar = m0 + row; ar = ar < M ? ar : M - 1;
      int br = n0 + row; br = br < N ? br : N - 1;
      aoff[i] = (size_t)ar * lda + kc * 8;
      boff[i] = (size_t)br * ldb + kc * 8;
    }
  };
  struct GRegs { u32x4 a[4], b[4]; };
  auto prefetch = [&](GRegs& R, int kt) {
#pragma unroll
    for (int i = 0; i < 4; ++i) {
      R.a[i] = *(const u32x4*)(A + aoff[i] + (size_t)kt * 64);
      R.b[i] = *(const u32x4*)(Bt + boff[i] + (size_t)kt * 64);
    }
  };
  auto lds_write = [&](const GRegs& R, int buf) {
#pragma unroll
    for (int i = 0; i < 4; ++i) {
      *(u32x4*)(As + buf * GBUF + soff[i]) = R.a[i];
      *(u32x4*)(Bs + buf * GBUF + soff[i]) = R.b[i];
    }
  };
  const int nk = K >> 6;
  GRegs RA, RB;
  int m0, n0;
  tmap(t, m0, n0);
  set_tile(m0, n0);
  prefetch(RA, 0);
  prefetch(RB, 1);
  for (;;) {
    f32x16 acc[2][2];
#pragma unroll
    for (int i = 0; i < 2; ++i)
#pragma unroll
      for (int j = 0; j < 2; ++j)
#pragma unroll
        for (int e = 0; e < 16; ++e) acc[i][j][e] = 0.f;
    auto compute = [&](int buf) {
      const u16* Ab = As + buf * GBUF;
      const u16* Bb = Bs + buf * GBUF;
#pragma unroll
      for (int ks = 0; ks < 4; ++ks) {
        bf16x8 af[2], bfr[2];
#pragma unroll
        for (int i = 0; i < 2; ++i) {
          af[i] = *(const bf16x8*)(Ab + (wm * 64 + i * 32 + r) * GLD + ks * 16 + hh * 8);
          bfr[i] = *(const bf16x8*)(Bb + (wn * 64 + i * 32 + r) * GLD + ks * 16 + hh * 8);
        }
#pragma unroll
        for (int i = 0; i < 2; ++i)
#pragma unroll
          for (int j = 0; j < 2; ++j) acc[i][j] = MFMA32(af[i], bfr[j], acc[i][j]);
      }
    };
    lds_write(RA, 0);
    __syncthreads();
    for (int kt = 0; kt < nk; kt += 2) {
      if (kt + 2 < nk) prefetch(RA, kt + 2);
      compute(0);
      lds_write(RB, 1);
      __syncthreads();
      if (kt + 3 < nk) prefetch(RB, kt + 3);
      compute(1);
      if (kt + 2 < nk) lds_write(RA, 0);
      __syncthreads();
    }
    const int tn = t + (int)gridDim.x;
    const bool more = tn < ntiles;
    const int cm0 = m0, cn0 = n0;
    if (more) {
      tmap(tn, m0, n0);
      set_tile(m0, n0);
      prefetch(RA, 0);
    }
#pragma unroll
    for (int i = 0; i < 2; ++i)
#pragma unroll
      for (int j = 0; j < 2; ++j) {
        const int col = cn0 + wn * 64 + j * 32 + r;
#pragma unroll
        for (int e = 0; e < 16; ++e) {
          const int row = cm0 + wm * 64 + i * 32 + (e & 3) + 8 * (e >> 2) + 4 * hh;
          epi(row, col, acc[i][j][e], (row < M) && (col < N));
        }
      }
    if (!more) break;
    prefetch(RB, 1);
    t = tn;
  }
}

struct EpiInproj {
  u16* prkv; u16* prest; float* out;
  DI void operator()(int row, int col, float v, bool valid) const {
    if (!valid) return;
    if (col < NRKV) prkv[(size_t)row * NRKV + col] = f2bf(v);
    else prest[(size_t)row * NREST + (col - NRKV)] = f2bf(v);
    if (col < CR) {
      if (row < TP) {
        if (row == LP - 1) out[O_SHIFTP + col] = v;
        else if (row == 2 * LP - 1) out[O_SHIFTP + CR + col] = v;
      } else {
        int s = row - TP;
        if ((s & 15) == 15) out[O_SHIFTS + (size_t)(s >> 4) * CR + col] = v;
      }
    }
  }
};
struct EpiDecay {
  float* wd; const float* base;
  DI void operator()(int row, int col, float v, bool valid) const {
    if (valid) wd[(size_t)row * 512 + col] = __expf(-DECAY_SCALE * sigmoidf_(base[col] + v));
  }
};
struct EpiAaa {
  u16* aa; const float* base;
  DI void operator()(int row, int col, float v, bool valid) const {
    if (valid) aa[(size_t)row * 512 + col] = f2bf(sigmoidf_(base[col] + v));
  }
};
struct EpiStoreBf {
  u16* dst; int ld;
  DI void operator()(int row, int col, float v, bool valid) const {
    if (valid) dst[(size_t)row * ld + col] = f2bf(v);
  }
};
struct EpiQ {
  u16* q; const float* cosT; const float* sinT;
  DI void operator()(int row, int col, float v, bool valid) const {
    int dcol = col % 96;
    float partner = __shfl_xor(v, 16);
    if (dcol >= 64) {
      int rr = row < MT ? row : MT - 1;
      int pos = rr < TP ? (rr % LP) : 2048 + ((rr - TP) & 15);
      int i = (dcol - 64) & 15;
      float c = cosT[pos * 16 + i], s = sinT[pos * 16 + i];
      v = (dcol < 80) ? (v * c - partner * s) : (partner * s + v * c);
    }
    if (valid) q[(size_t)row * 768 + col] = f2bf(v * QSCALE);
  }
};
struct EpiOut {
  const float* x; const float* xs; const float* stats; const float* g; const float* b; float* out;
  DI void operator()(int row, int col, float v, bool valid) const {
    if (!valid) return;
    int m = row < 16384 ? ((row >> 13) * LP + 16 + (row & 8191)) : (TP + row - 16384);
    float mu = stats[2 * m], rs = stats[2 * m + 1];
    const float xv = row < 16384 ? x[(size_t)row * 1024 + col] : xs[(size_t)(row - 16384) * 1024 + col];
    float h = (xv - mu) * rs * g[col] + b[col];
    out[(size_t)row * 1024 + col] = ALPHA * h + v;
  }
};
struct EpiUp {
  u16* act;
  DI void operator()(int row, int col, float v, bool valid) const {
    if (valid) { float t = v > 0.f ? v : 0.f; act[(size_t)row * 4096 + col] = f2bf(t * t); }
  }
};
struct EpiDown {
  float* out;
  DI void operator()(int row, int col, float v, bool valid) const {
    if (valid) { size_t o = (size_t)row * 1024 + col; out[o] = ALPHA * out[o] + v; }
  }
};

__device__ __forceinline__ void transpose_tiles(const float* __restrict__ src, int ld_src, u16* __restrict__ dst, int K, int Nd, int mode,
                                float* tl) {
  const int tid = threadIdx.x, tx = tid & 31, ty = tid >> 5;
  const int ntn = Nd >> 5, ntk = K >> 5;
  for (int t = blockIdx.x; t < ntn * ntk; t += gridDim.x) {
    int tn = t % ntn, tk = t / ntn;
    int n0 = tn * 32, k0 = tk * 32;
    int n = n0 + tx;
    int sc = mode == 0 ? n : ((n >> 6) * 128 + (n & 63) + (mode == 2 ? 64 : 0));
#pragma unroll
    for (int i = 0; i < 4; ++i) {
      int k = k0 + ty + 8 * i;
      tl[(ty + 8 * i) * 33 + tx] = src[(size_t)k * ld_src + sc];
    }
    __syncthreads();
#pragma unroll
    for (int i = 0; i < 4; ++i) {
      int nn = ty + 8 * i;
      dst[(size_t)(n0 + nn) * K + k0 + tx] = f2bf(tl[tx * 33 + nn]);
    }
    __syncthreads();
  }
}

__device__ __forceinline__ void phase_prep(const Params& p, char* smem) {
  char* ws = p.ws;
  float* tl = (float*)smem;
  transpose_tiles(p.in[9], CIN, (u16*)(ws + OFF_WIN), 1024, CIN, 0, tl);
  transpose_tiles(p.in[22], 768, (u16*)(ws + OFF_WQB), 384, 768, 0, tl);
  transpose_tiles(p.in[24], 1024, (u16*)(ws + OFF_WKN), 256, 512, 1, tl);
  transpose_tiles(p.in[24], 1024, (u16*)(ws + OFF_WV), 256, 512, 2, tl);
  transpose_tiles(p.in[11], 512, (u16*)(ws + OFF_WDEC), 64, 512, 0, tl);
  transpose_tiles(p.in[13], 512, (u16*)(ws + OFF_WAAA), 64, 512, 0, tl);
  transpose_tiles(p.in[15], 512, (u16*)(ws + OFF_WGATE), 128, 512, 0, tl);
  transpose_tiles(p.in[26], 1024, (u16*)(ws + OFF_WOUT), 1024, 1024, 0, tl);
  transpose_tiles(p.in[29], 4096, (u16*)(ws + OFF_WUP), 1024, 4096, 0, tl);
  transpose_tiles(p.in[30], 1024, (u16*)(ws + OFF_WDOWN), 4096, 1024, 0, tl);

  const int tid = threadIdx.x, lane = tid & 63, wave = tid >> 6;
  {
    u16* Hb = (u16*)(ws + OFF_R2);
    float* stats = (float*)(ws + OFF_STATS);
    const float* g = p.in[7]; const float* bb = p.in[8];
    auto rowsrc = [&](int m) -> const float* {
      if (m < TP) { int b = m / LP, l = m % LP; return l < 16 ? p.in[6] + (size_t)l * 1024 : p.in[0] + ((size_t)b * 8192 + (l - 16)) * 1024; }
      return p.in[1] + (size_t)(m - TP) * 1024;
    };
    const int stride = gridDim.x * 4;
    int m = blockIdx.x * 4 + wave;
    float4 v[4], vn[4];
    if (m < MT) {
      const float* src = rowsrc(m);
#pragma unroll
      for (int i = 0; i < 4; ++i) v[i] = *(const float4*)(src + lane * 4 + 256 * i);
    }
    for (; m < MT; m += stride) {
      const int mn = m + stride;
      {
        const float* srcn = rowsrc(mn < MT ? mn : m);
#pragma unroll
        for (int i = 0; i < 4; ++i) vn[i] = *(const float4*)(srcn + lane * 4 + 256 * i);
      }
      float s = 0.f;
#pragma unroll
      for (int i = 0; i < 4; ++i) s += v[i].x + v[i].y + v[i].z + v[i].w;
      float mu = wave_sum(s) * (1.0f / 1024.0f);
      float q = 0.f;
#pragma unroll
      for (int i = 0; i < 4; ++i) { float a = v[i].x - mu, b2 = v[i].y - mu, c = v[i].z - mu, d = v[i].w - mu; q += a * a + b2 * b2 + c * c + d * d; }
      float rs = rsqrtf(wave_sum(q) * (1.0f / 1024.0f) + 1e-5f);
      if (lane == 0) { stats[2 * m] = mu; stats[2 * m + 1] = rs; }
#pragma unroll
      for (int i = 0; i < 4; ++i) {
        int c = lane * 4 + 256 * i;
        float4 gg = *(const float4*)(g + c), b4 = *(const float4*)(bb + c);
        uint2 o;
        o.x = pack2((v[i].x - mu) * rs * gg.x + b4.x, (v[i].y - mu) * rs * gg.y + b4.y);
        o.y = pack2((v[i].z - mu) * rs * gg.z + b4.z, (v[i].w - mu) * rs * gg.w + b4.w);
        *(uint2*)(Hb + (size_t)m * 1024 + c) = o;
      }
#pragma unroll
      for (int i = 0; i < 4; ++i) v[i] = vn[i];
    }
  }
  const size_t gtid = (size_t)blockIdx.x * 256 + tid, gsz = (size_t)gridDim.x * 256;
  {
    float* cosT = (float*)(ws + OFF_ROPE); float* sinT = cosT + LP * 16;
    for (size_t e = gtid; e < (size_t)LP * 16; e += gsz) {
      int pos = (int)(e >> 4), i = (int)(e & 15);
      double inv = exp(-(double)(2 * i) / 32.0 * 9.210340371976184);
      double rev = (double)pos * inv * 0.15915494309189535;
      rev -= rint(rev);
      float rf = (float)rev;
      cosT[e] = __builtin_amdgcn_cosf(rf);
      sinT[e] = __builtin_amdgcn_sinf(rf);
    }
  }
  {
    u16* CbS = (u16*)((char*)p.out + SC_CBS);
    const float* cl = p.in[2];
    for (size_t e0 = gtid; e0 < (size_t)16 * 2048 * 64; e0 += 4 * gsz) {
      float4 v[4]; size_t ee[4];
#pragma unroll
      for (int u = 0; u < 4; ++u) {
        ee[u] = e0 + u * gsz; if (ee[u] >= (size_t)16 * 2048 * 64) ee[u] = e0;
        v[u] = *(const float4*)(cl + (ee[u] >> 6) * 256 + (ee[u] & 63) * 4);
      }
#pragma unroll
      for (int u = 0; u < 4; ++u) {
        size_t row = ee[u] >> 6; int c4 = (int)(ee[u] & 63);
        int b = (int)(row >> 11), key = (int)(row & 2047);
        uint2 o; o.x = pack2(v[u].x, v[u].y); o.y = pack2(v[u].z, v[u].w);
        *(uint2*)(CbS + ((size_t)b * LKS + key) * 256 + c4 * 4) = o;
      }
    }
    u16* KRs = (u16*)(ws + OFF_KRS);
    const float* cr = p.in[3];
    for (size_t e = gtid; e < (size_t)16 * 2048 * 8; e += gsz) {
      size_t row = e >> 3; int c4 = (int)(e & 7);
      int b = (int)(row >> 11), key = (int)(row & 2047);
      float4 v = *(const float4*)(cr + row * 32 + c4 * 4);
      uint2 o; o.x = pack2(v.x, v.y); o.y = pack2(v.z, v.w);
      *(uint2*)(KRs + ((size_t)b * LKS + key) * 32 + c4 * 4) = o;
    }
  }
}

__device__ __forceinline__ void phase_postproj(const Params& p) {
  char* ws = p.ws;
  const int lane = threadIdx.x & 63, wave = threadIdx.x >> 6;
  const u16* Prest = (const u16*)(ws + OFF_R6);
  u16* Lin = (u16*)((char*)p.out + SC_LIN);
  u16* Qn = (u16*)((char*)p.out + SC_QN);
  u16* CbP = (u16*)((char*)p.out + SC_CBP);
  u16* CbS = (u16*)((char*)p.out + SC_CBS);
  u16* KRp = (u16*)(ws + OFF_KRP);
  u16* KRs = (u16*)(ws + OFF_KRS);
  const float* cosT = (const float*)(ws + OFF_ROPE); const float* sinT = cosT + LP * 16;
  const float* mu_shift = p.in[10];
  const float* sshift = p.in[5];
  const float* qg = p.in[21]; const float* kvg = p.in[23];
  for (int m = blockIdx.x * 4 + wave; m < MT; m += gridDim.x * 4) {
    const bool prompt = m < TP;
    int b, l;
    if (prompt) { b = m / LP; l = m % LP; } else { b = (m - TP) >> 4; l = (m - TP) & 15; }
    const u16* row = Prest + (size_t)m * NREST;
#pragma unroll
    for (int i = 0; i < 4; ++i) {
      int c = lane + 64 * i;
      float cur = bf2f(row[c]);
      float prev;
      if (l > 0) prev = bf2f(row[c - NREST]);
      else prev = prompt ? 0.f : sshift[(size_t)b * CR + NRKV + c];
      float x = cur + mu_shift[NRKV + c] * (prev - cur);
      float o = i == 0 ? tanhf_(x) : (i == 1 ? x : sigmoidf_(x));
      Lin[(size_t)m * 256 + c] = f2bf(o);
    }
    {
      float v[6]; float ss = 0.f;
#pragma unroll
      for (int i = 0; i < 6; ++i) { v[i] = bf2f(row[256 + lane + 64 * i]); ss += v[i] * v[i]; }
      float rs = rsqrtf(wave_sum(ss) * (1.0f / 384.0f) + 1e-6f);
#pragma unroll
      for (int i = 0; i < 6; ++i) Qn[(size_t)m * 384 + lane + 64 * i] = f2bf(v[i] * rs * qg[lane + 64 * i]);
    }
    {
      float v[4]; float ss = 0.f;
#pragma unroll
      for (int i = 0; i < 4; ++i) { v[i] = bf2f(row[640 + lane + 64 * i]); ss += v[i] * v[i]; }
      float rs = rsqrtf(wave_sum(ss) * (1.0f / 256.0f) + 1e-6f);
      float* lo = prompt ? p.out + O_LATP + (size_t)m * 256 : p.out + O_LATS + (size_t)(m - TP) * 256;
      u16* cb = prompt ? CbP + (size_t)m * 256 : CbS + ((size_t)b * LKS + 2048 + l) * 256;
#pragma unroll
      for (int i = 0; i < 4; ++i) {
        float c = v[i] * rs * kvg[lane + 64 * i];
        lo[lane + 64 * i] = c;
        cb[lane + 64 * i] = f2bf(c);
      }
    }
    {
      int i = lane & 15;
      float x1 = bf2f(row[896 + i]), x2 = bf2f(row[912 + i]);
      int pos = prompt ? l : 2048 + l;
      float c = cosT[pos * 16 + i], s = sinT[pos * 16 + i];
      float o1 = x1 * c - x2 * s, o2 = x1 * s + x2 * c;
      float* ro = prompt ? p.out + O_ROPEP + (size_t)m * 32 : p.out + O_ROPES + (size_t)(m - TP) * 32;
      u16* kr = prompt ? KRp + (size_t)m * 32 : KRs + ((size_t)b * LKS + 2048 + l) * 32;
      if (lane < 16) { ro[i] = o1; ro[16 + i] = o2; kr[i] = f2bf(o1); kr[16 + i] = f2bf(o2); }
    }
  }
}

struct ShiftSave { unsigned d[12]; };
__device__ __forceinline__ void shift_save(const Params& p, ShiftSave& sv) {
  const int lane = threadIdx.x & 63, wave = threadIdx.x >> 6;
  const int tpw = (MT + (int)gridDim.x * 4 - 1) / ((int)gridDim.x * 4);
  const int m_lo = (blockIdx.x * 4 + wave) * tpw;
  const unsigned* Pd = (const unsigned*)(p.ws + OFF_PRKV);
  const int mr = (m_lo > 0 && m_lo < MT) ? m_lo - 1 : 0;
#pragma unroll
  for (int i = 0; i < 12; ++i) sv.d[i] = Pd[(size_t)mr * (NRKV / 2) + lane + 64 * i];
}
__device__ __forceinline__ void shift_apply(const Params& p, const ShiftSave& sv) {
  const int lane = threadIdx.x & 63, wave = threadIdx.x >> 6;
  const int tpw = (MT + (int)gridDim.x * 4 - 1) / ((int)gridDim.x * 4);
  const int m_lo = (blockIdx.x * 4 + wave) * tpw;
  if (m_lo >= MT) return;
  const int m_hi = (m_lo + tpw < MT) ? m_lo + tpw : MT;
  unsigned* Pd = (unsigned*)(p.ws + OFF_PRKV);
  float* PRE8 = (float*)(p.ws + OFF_PRE8);
  const float* mu = p.in[10];
  const float* k_k = p.in[16];
  for (int m = m_hi - 1; m >= m_lo; --m) {
    const bool prompt = m < TP;
    int b, l;
    if (prompt) { b = m / LP; l = m % LP; } else { b = (m - TP) >> 4; l = (m - TP) & 15; }
    unsigned* row = Pd + (size_t)m * (NRKV / 2);
    unsigned cur[12], prv[12];
#pragma unroll
    for (int i = 0; i < 12; ++i) cur[i] = row[lane + 64 * i];
    if (l > 0 && m > m_lo) {
#pragma unroll
      for (int i = 0; i < 12; ++i) prv[i] = row[lane + 64 * i - NRKV / 2];
    } else {
#pragma unroll
      for (int i = 0; i < 12; ++i) prv[i] = sv.d[i];
    }
#pragma unroll
    for (int i = 0; i < 12; ++i) {
      const int c = 2 * (lane + 64 * i);
      float c0 = __uint_as_float(cur[i] << 16), c1 = __uint_as_float(cur[i] & 0xFFFF0000u);
      float p0 = __uint_as_float(prv[i] << 16), p1 = __uint_as_float(prv[i] & 0xFFFF0000u);
      if (l == 0) {
        if (prompt) { p0 = 0.f; p1 = 0.f; }
        else { const float2 q = *(const float2*)(p.in[5] + (size_t)b * CR + c); p0 = q.x; p1 = q.y; }
      }
      const float2 mm = *(const float2*)(mu + c);
      const float o0 = c0 + mm.x * (p0 - c0), o1 = c1 + mm.y * (p1 - c1);
      row[lane + 64 * i] = pack2(o0, o1);
      if (i >= 4 && i < 8) {
        const float2 kw = *(const float2*)(k_k + c - 512);
        const float q0 = o0 * kw.x, q1 = o1 * kw.y;
        const float ss = allreduce32(fmaf(q0, q0, q1 * q1));
        if ((lane & 31) == 0) PRE8[(size_t)m * 8 + 2 * (i - 4) + (lane >> 5)] = __builtin_amdgcn_rsqf(fmaxf(ss, 1e-24f));
      }
    }
  }
}

__device__ __forceinline__ void phase_gemms3(const Params& p, u16* smem) {
  char* ws = p.ws;
  const u16* Lin = (const u16*)((char*)p.out + SC_LIN);
  const u16* Qn = (const u16*)((char*)p.out + SC_QN);
  const u16* CbP = (const u16*)((char*)p.out + SC_CBP);
  const u16* CbS = (const u16*)((char*)p.out + SC_CBS);
  constexpr int TM = (MT + 127) / 128;
  constexpr int TMP = (TP + 127) / 128;
  constexpr int TMS = TKS / 128;
  constexpr int J0 = TM * 4, J1 = J0 + TM * 4, J2 = J1 + TM * 4, J3 = J2 + TM * 6, J4 = J3 + TMP * 4, J5 = J4 + TMP * 4,
                J6 = J5 + TMS * 4, J7 = J6 + TMS * 4;
  for (int t = blockIdx.x; t < J7; t += gridDim.x) {
    if (t < J0) {
      EpiDecay e{(float*)(ws + OFF_R2), p.in[12]};
      gemm_tile(Lin, 256, (const u16*)(ws + OFF_WDEC), 64, MT, 512, 64, (t >> 2) * 128, (t & 3) * 128, e, smem);
    } else if (t < J1) {
      int u = t - J0;
      EpiAaa e{(u16*)((char*)p.out + SC_AA), p.in[14]};
      gemm_tile(Lin + 64, 256, (const u16*)(ws + OFF_WAAA), 64, MT, 512, 64, (u >> 2) * 128, (u & 3) * 128, e, smem);
    } else if (t < J2) {
      int u = t - J1;
      EpiStoreBf e{(u16*)(ws + OFF_GG), 512};
      gemm_tile(Lin + 128, 256, (const u16*)(ws + OFF_WGATE), 128, MT, 512, 128, (u >> 2) * 128, (u & 3) * 128, e, smem);
    } else if (t < J3) {
      int u = t - J2;
      EpiQ e{(u16*)(ws + OFF_Q), (const float*)(ws + OFF_ROPE), (const float*)(ws + OFF_ROPE) + LP * 16};
      gemm_tile(Qn, 384, (const u16*)(ws + OFF_WQB), 384, MT, 768, 384, (u / 6) * 128, (u % 6) * 128, e, smem);
    } else if (t < J4) {
      int u = t - J3;
      EpiStoreBf e{(u16*)(ws + OFF_KNP), 512};
      gemm_tile(CbP, 256, (const u16*)(ws + OFF_WKN), 256, TP, 512, 256, (u >> 2) * 128, (u & 3) * 128, e, smem);
    } else if (t < J5) {
      int u = t - J4;
      EpiStoreBf e{(u16*)(ws + OFF_VTP), LDVP};
      gemm_tile((const u16*)(ws + OFF_WV), 256, CbP, 256, 512, TP, 256, (u & 3) * 128, (u >> 2) * 128, e, smem);
    } else if (t < J6) {
      int u = t - J5;
      EpiStoreBf e{(u16*)(ws + OFF_R6), 512};
      gemm_tile(CbS, 256, (const u16*)(ws + OFF_WKN), 256, TKS, 512, 256, (u >> 2) * 128, (u & 3) * 128, e, smem);
    } else {
      int u = t - J6;
      EpiStoreBf e{(u16*)(ws + OFF_VTS), LDVS};
      gemm_tile((const u16*)(ws + OFF_WV), 256, CbS, 256, 512, TKS, 256, (u & 3) * 128, (u >> 2) * 128, e, smem);
    }
  }
}

constexpr int SB_A4 = 0, SB_B4 = 2560, SB_R2 = 5120, SB_VV = 6400, SB_SIZE = 6480;
constexpr int SB_YP = 2 * SB_SIZE, SB_YPSZ = 64 * 36;
DI float afma(float a, float b, float c) { float r; asm("v_fma_f32 %0, %1, %2, %3" : "=v"(r) : "v"(a), "v"(b), "v"(c)); return r; }
DI float amul(float a, float b) { float r; asm("v_mul_f32 %0, %1, %2" : "=v"(r) : "v"(a), "v"(b)); return r; }
DI void lds_barrier() { asm volatile("s_waitcnt lgkmcnt(0)\n\ts_barrier" ::: "memory"); }
DI float bflo(unsigned u) { return __uint_as_float(u << 16); }
DI float bfhi(unsigned u) { return __uint_as_float(u & 0xFFFF0000u); }
struct ScanRaw { unsigned rs[4], ks[4], av[4]; float2 wv[4]; float inv[4]; float vs; };
__device__ __forceinline__ void scan_item(const Params& p, bool prompt, int b, int h, int grp, float* smem) {
  char* ws = p.ws;
  const int tid = threadIdx.x, lane = tid & 63, wave = tid >> 6;
  const u16* Prkv = (const u16*)(ws + OFF_PRKV);
  const float* Wd = (const float*)(ws + OFF_R2);
  const u16* Aa = (const u16*)((const char*)p.out + SC_AA);
  u16* Yb = (u16*)((char*)p.out + SC_YB);
  const int L = prompt ? LP : 16;
  const int nchunks = L / 16;
  const size_t mbase = prompt ? (size_t)b * LP : (size_t)TP + b * 16;
  const int c2 = lane & 31, ts = lane >> 5;

  if (wave < 2) {
    const int row4 = wave * 2 + ts;
    const int irow = grp * 4 + row4;
    const size_t sidx = (((size_t)b * 8 + h) * 64 + irow) * 64 + c2 * 2;
    float s0 = 0.f, s1 = 0.f;
    if (!prompt) { float2 t = *(const float2*)(p.in[4] + sidx); s0 = t.x; s1 = t.y; }
    lds_barrier();
    for (int c = 0; c < nchunks; ++c) {
      const float* pa = smem + (c & 1) * SB_SIZE + SB_A4 + c2 * 4;
      const float* pb = smem + (c & 1) * SB_SIZE + SB_B4 + c2 * 4;
      const float* pr = smem + (c & 1) * SB_SIZE + SB_R2 + c2 * 2;
      const float* pv = smem + (c & 1) * SB_SIZE + SB_VV + row4 * 20;
      float* py = smem + SB_YP + (c & 1) * SB_YPSZ + row4 * 36 + c2;
      float4 Aq[4], Bq[4]; float2 Rq[4];
      float4 Vc = *(const float4*)(pv), Vn = *(const float4*)(pv + 4);
#pragma unroll
      for (int i = 0; i < 4; ++i) {
        Aq[i] = *(const float4*)(pa + i * 128); Bq[i] = *(const float4*)(pb + i * 128);
        Rq[i] = *(const float2*)(pr + i * 64);
      }
#pragma unroll
      for (int t = 0; t < 16; ++t) {
        const int sl = t & 3;
        if (sl == 0 && t > 0) { Vc = Vn; Vn = *(const float4*)(pv + t + 4); }
        const float4 A0 = Aq[sl], B0 = Bq[sl]; const float2 R0 = Rq[sl];
        const float v0 = sl == 0 ? Vc.x : (sl == 1 ? Vc.y : (sl == 2 ? Vc.z : Vc.w));
        Aq[sl] = *(const float4*)(pa + (t + 4) * 128); Bq[sl] = *(const float4*)(pb + (t + 4) * 128);
        Rq[sl] = *(const float2*)(pr + (t + 4) * 64);
        float sa = amul(s0, A0.z) + amul(s1, A0.w);
        const float d0 = afma(v0, B0.z, amul(s0, A0.x)), d1 = afma(v0, B0.w, amul(s1, A0.y));
        sa = allreduce32(sa);
        s0 = afma(sa, B0.x, d0); s1 = afma(sa, B0.y, d1);
        py[t * 144] = amul(s0, R0.x) + amul(s1, R0.y);
      }
      lds_barrier();
    }
    float* so = p.out + (prompt ? O_STATEP : O_STATES) + sidx;
    *(float2*)so = make_float2(s0, s1);
  } else {
    const int ubeg = wave == 2 ? 0 : 4;
    const int hc = h * 64 + 2 * c2;
    const float2 kkw = *(const float2*)(p.in[16] + hc), kaw = *(const float2*)(p.in[17] + hc);
    const int vr4 = lane & 3, vtt = lane >> 2;
    const int vcol = h * 64 + grp * 4 + vr4;
    const float* PRE8 = (const float*)(ws + OFF_PRE8);
    auto prefetch = [&](ScanRaw& R, int chunk) {
      chunk = chunk < nchunks ? chunk : nchunks - 1;
      const int t0 = chunk * 16;
#pragma unroll
      for (int i = 0; i < 4; ++i) {
        const size_t m = mbase + t0 + 2 * (ubeg + i) + ts;
        const u16* row = Prkv + m * NRKV;
        R.rs[i] = *(const unsigned*)(row + hc); R.ks[i] = *(const unsigned*)(row + 512 + hc);
        R.wv[i] = *(const float2*)(Wd + m * 512 + hc);
        R.av[i] = *(const unsigned*)(Aa + m * 512 + hc);
        R.inv[i] = PRE8[m * 8 + h];
      }
      R.vs = bf2f(Prkv[(mbase + t0 + vtt) * NRKV + 1024 + vcol]);
    };
    auto stage = [&](const ScanRaw& R, float* buf) {
#pragma unroll
      for (int i = 0; i < 4; ++i) {
        const int tt = 2 * (ubeg + i) + ts;
        const float r0 = bflo(R.rs[i]), r1 = bfhi(R.rs[i]);
        const float k0 = bflo(R.ks[i]), k1 = bfhi(R.ks[i]);
        const float a0 = bflo(R.av[i]), a1 = bfhi(R.av[i]);
        const float kk0 = k0 * kkw.x * R.inv[i], kk1 = k1 * kkw.y * R.inv[i];
        const float kt0 = k0 * (1.0f + (a0 - 1.0f) * kaw.x), kt1 = k1 * (1.0f + (a1 - 1.0f) * kaw.y);
        *(float4*)(buf + SB_A4 + (tt * 32 + c2) * 4) = make_float4(R.wv[i].x, R.wv[i].y, -kk0, -kk1);
        *(float4*)(buf + SB_B4 + (tt * 32 + c2) * 4) = make_float4(kk0 * a0, kk1 * a1, kt0, kt1);
        *(float2*)(buf + SB_R2 + (tt * 32 + c2) * 2) = make_float2(r0, r1);
      }
      if (wave == 3) buf[SB_VV + vr4 * 20 + vtt] = R.vs;
    };
    auto yflush = [&](int chunk) {
      chunk = chunk < 0 ? 0 : chunk;
      const float4* yp = (const float4*)(smem + SB_YP + (chunk & 1) * SB_YPSZ + lane * 36);
      float4 acc = yp[0];
#pragma unroll
      for (int i = 1; i < 8; ++i) { const float4 q = yp[i]; acc.x += q.x; acc.y += q.y; acc.z += q.z; acc.w += q.w; }
      const float y = (acc.x + acc.y) + (acc.z + acc.w);
      Yb[(mbase + chunk * 16 + vtt) * 512 + vcol] = f2bf(y);
    };
    ScanRaw S0, S1;
    prefetch(S0, 0);
    prefetch(S1, 1);
    stage(S0, smem);
    prefetch(S0, 2);
    lds_barrier();
    int c = 0;
    for (; c + 1 < nchunks; c += 2) {
      stage(S1, smem + SB_SIZE);
      prefetch(S1, c + 3);
      if (wave == 2) yflush(c - 1);
      lds_barrier();
      stage(S0, smem);
      prefetch(S0, c + 4);
      if (wave == 2) yflush(c);
      lds_barrier();
    }
    if (wave == 2) yflush(c - 1);
    lds_barrier();
    if (wave == 2) yflush(nchunks - 1);
  }
  __syncthreads();
}

constexpr int KLD = 104;
constexpr int VLD = 68;
constexpr int ATT_BUF = 64 * KLD + 64 * VLD;
__device__ __forceinline__ void attn_item(const u16* __restrict__ Q, int qrow_lim, const u16* __restrict__ Kn, const u16* __restrict__ KR,
                          const u16* __restrict__ Vt, int ldv, int first_valid, int nk_lo, int nk_hi, u16* __restrict__ O,
                          int q_valid, u16* smem) {
  u16* Ks = smem;
  u16* Vs = smem + 64 * KLD;
  const int tid = threadIdx.x, lane = tid & 63, wave = tid >> 6;
  const int r = lane & 31, hh = lane >> 5;
  const int my_nk = wave < 2 ? nk_lo : nk_hi;
  auto ntiles = [&](int nk) { return nk <= first_valid ? 1 : 1 + (nk - first_valid + 63) / 64; };
  const int nt_all = ntiles(nk_hi);
  const int my_nt = (wave * 32 < q_valid) ? ntiles(my_nk) : 0;
  bf16x8 qf[6];
  {
    int qr = wave * 32 + r; qr = qr < qrow_lim ? qr : qrow_lim - 1;
    const u16* qp = Q + (size_t)qr * 768 + hh * 8;
#pragma unroll
    for (int ks = 0; ks < 6; ++ks) qf[ks] = *(const bf16x8*)(qp + ks * 16);
  }
  int kkey[3], kch[3];
#pragma unroll
  for (int i = 0; i < 3; ++i) { int id = tid + 256 * i; kkey[i] = id / 12; kch[i] = id % 12; }
  struct KVRegs { u32x4 rk[3]; u32x4 rv[2]; };
  auto prefetch = [&](KVRegs& R, int kt) {
    int start = kt == 0 ? 0 : first_valid + 64 * (kt - 1);
#pragma unroll
    for (int i = 0; i < 3; ++i) {
      size_t key = (size_t)(start + kkey[i]);
      const u16* src = kch[i] < 8 ? Kn + key * 512 + kch[i] * 8 : KR + key * 32 + (kch[i] - 8) * 8;
      R.rk[i] = *(const u32x4*)src;
    }
#pragma unroll
    for (int i = 0; i < 2; ++i) {
      int id = tid + 256 * i; int d = id >> 3, ch = id & 7;
      R.rv[i] = *(const u32x4*)(Vt + (size_t)d * ldv + start + ch * 8);
    }
  };
  auto lds_write = [&](const KVRegs& R, int buf) {
    u16* Kb = Ks + buf * ATT_BUF;
    u16* Vb = Vs + buf * ATT_BUF;
#pragma unroll
    for (int i = 0; i < 3; ++i) *(u32x4*)(Kb + kkey[i] * KLD + kch[i] * 8) = R.rk[i];
#pragma unroll
    for (int i = 0; i < 2; ++i) {
      int id = tid + 256 * i; int d = id >> 3, ch = id & 7;
      u32x2* dst = (u32x2*)(Vb + d * VLD + ch * 8);
      u32x2 t0 = {R.rv[i].x, R.rv[i].y}, t1 = {R.rv[i].z, R.rv[i].w};
      dst[0] = t0;
      dst[1] = t1;
    }
  };
  f32x16 o[2];
#pragma unroll
  for (int i = 0; i < 2; ++i)
#pragma unroll
    for (int e = 0; e < 16; ++e) o[i][e] = 0.f;
  float m_run = -1e30f, l_run = 0.f;
  auto compute = [&](int kt) {
    const u16* Kb = Ks + (kt & 1) * ATT_BUF;
    const u16* Vb = Vs + (kt & 1) * ATT_BUF;
    const int start = kt == 0 ? 0 : first_valid + 64 * (kt - 1);
    int tv = kt == 0 ? first_valid : 64;
    if (my_nk - start < tv) tv = my_nk - start;
    f32x16 s[2];
#pragma unroll
    for (int T = 0; T < 2; ++T)
#pragma unroll
      for (int e = 0; e < 16; ++e) s[T][e] = 0.f;
#pragma unroll
    for (int ks = 0; ks < 6; ++ks) {
#pragma unroll
      for (int T = 0; T < 2; ++T) {
        bf16x8 kf = *(const bf16x8*)(Kb + (T * 32 + r) * KLD + ks * 16 + hh * 8);
        s[T] = MFMA32(kf, qf[ks], s[T]);
      }
    }
    if (tv < 64) {
#pragma unroll
      for (int T = 0; T < 2; ++T)
#pragma unroll
        for (int e = 0; e < 16; ++e) {
          int kidx = T * 32 + (e & 3) + 8 * (e >> 2) + 4 * hh;
          if (kidx >= tv) s[T][e] = -1e30f;
        }
    }
    float mx = s[0][0];
#pragma unroll
    for (int T = 0; T < 2; ++T)
#pragma unroll
      for (int e = 0; e < 16; ++e) mx = fmaxf(mx, s[T][e]);
    mx = fmaxf(mx, __shfl_xor(mx, 32));
    const float m_new = fmaxf(m_run, mx);
    const float alpha = __builtin_amdgcn_exp2f(m_run - m_new);
    m_run = m_new;
    float rsum = 0.f;
#pragma unroll
    for (int T = 0; T < 2; ++T)
#pragma unroll
      for (int e = 0; e < 16; ++e) { float pv = __builtin_amdgcn_exp2f(s[T][e] - m_new); s[T][e] = pv; rsum += pv; }
    l_run = l_run * alpha + rsum;
#pragma unroll
    for (int i = 0; i < 2; ++i)
#pragma unroll
      for (int e = 0; e < 16; ++e) o[i][e] *= alpha;
#pragma unroll
    for (int T = 0; T < 2; ++T)
#pragma unroll
      for (int ss = 0; ss < 2; ++ss) {
        uint4 pk;
        pk.x = pack2(s[T][8 * ss + 0], s[T][8 * ss + 1]);
        pk.y = pack2(s[T][8 * ss + 2], s[T][8 * ss + 3]);
        pk.z = pack2(s[T][8 * ss + 4], s[T][8 * ss + 5]);
        pk.w = pack2(s[T][8 * ss + 6], s[T][8 * ss + 7]);
        bf16x8 pf = __builtin_bit_cast(bf16x8, pk);
#pragma unroll
        for (int dt = 0; dt < 2; ++dt) {
          const u16* vp = Vb + (dt * 32 + r) * VLD + 32 * T + 16 * ss + 4 * hh;
          uint2 lo = *(const uint2*)vp;
          uint2 hi = *(const uint2*)(vp + 8);
          uint4 vv = make_uint4(lo.x, lo.y, hi.x, hi.y);
          o[dt] = MFMA32(__builtin_bit_cast(bf16x8, vv), pf, o[dt]);
        }
      }
  };
  KVRegs RA, RB;
  prefetch(RA, 0);
  if (1 < nt_all) prefetch(RB, 1);
  lds_write(RA, 0);
  __syncthreads();
  for (int kt = 0; kt < nt_all; kt += 2) {
    if (kt + 2 < nt_all) prefetch(RA, kt + 2);
    if (kt < my_nt) compute(kt);
    if (kt + 1 < nt_all) lds_write(RB, 1);
    __syncthreads();
    if (kt + 1 < nt_all) {
      if (kt + 3 < nt_all) prefetch(RB, kt + 3);
      if (kt + 1 < my_nt) compute(kt + 1);
      if (kt + 2 < nt_all) lds_write(RA, 0);
      __syncthreads();
    }
  }
  if (my_nt > 0) {
    float l = l_run + __shfl_xor(l_run, 32);
    float inv = 1.0f / l;
    int qr = wave * 32 + r;
    if (qr < q_valid) {
#pragma unroll
      for (int dt = 0; dt < 2; ++dt)
#pragma unroll
        for (int g = 0; g < 4; ++g) {
          uint2 st;
          st.x = pack2(o[dt][4 * g + 0] * inv, o[dt][4 * g + 1] * inv);
          st.y = pack2(o[dt][4 * g + 2] * inv, o[dt][4 * g + 3] * inv);
          *(uint2*)(O + (size_t)qr * 512 + dt * 32 + 8 * g + 4 * hh) = st;
        }
    }
  }
  __syncthreads();
}

__device__ __forceinline__ void phase_mixers(const Params& p, char* smem) {
  char* ws = p.ws;
#ifndef SUBM
#define SUBM 3
#endif
  if (SUBM & 1) {
    for (int it = blockIdx.x; it < 2048; it += gridDim.x) scan_item(p, false, it >> 7, (it >> 4) & 7, it & 15, (float*)smem);
    for (int it = blockIdx.x; it < 256; it += gridDim.x) scan_item(p, true, it >> 7, (it >> 4) & 7, it & 15, (float*)smem);
  }
  if (SUBM & 2) {
    int* cnt = (int*)(ws + OFF_CNT);
    int* sitem = (int*)(smem + 81472);
    const u16* Q = (const u16*)(ws + OFF_Q);
    u16* Oat = (u16*)((char*)p.out + SC_OAT);
    constexpr int NITEMS = 128 + 1024 + 16;
    for (;;) {
      if (threadIdx.x == 0) *sitem = atomicAdd(cnt, 1);
      __syncthreads();
      const int it = *sitem;
      __syncthreads();
      if (it >= NITEMS) break;
      size_t q0, k0; int h, ldv, fv, nlo, nhi, qv;
      const u16 *kn, *kr, *vt;
      if (it < 128) {
        int b = it >> 3; h = it & 7;
        q0 = (size_t)TP + b * 16; k0 = (size_t)b * LKS;
        kn = (const u16*)(ws + OFF_R6); kr = (const u16*)(ws + OFF_KRS); vt = (const u16*)(ws + OFF_VTS);
        ldv = LDVS; fv = 64; nlo = LKS; nhi = LKS; qv = 16;
      } else {
        kn = (const u16*)(ws + OFF_KNP); kr = (const u16*)(ws + OFF_KRP); vt = (const u16*)(ws + OFF_VTP);
        ldv = LDVP; fv = 16;
        if (it < 1152) {
          int j = it - 128;
          int qb = 63 - (j >> 4), b = (j >> 3) & 1; h = j & 7;
          k0 = (size_t)b * LP; q0 = k0 + 16 + 128 * qb;
          nlo = 16 + 64 * (2 * qb + 1); nhi = 16 + 64 * (2 * qb + 2); qv = 128;
        } else {
          int j = it - 1152;
          int b = j >> 3; h = j & 7;
          k0 = (size_t)b * LP; q0 = k0;
          nlo = 16; nhi = 16; qv = 16;
        }
      }
      attn_item(Q + q0 * 768 + h * 96, MT - (int)q0, kn + k0 * 512 + h * 64, kr + k0 * 32, vt + (size_t)(h * 64) * ldv + k0, ldv, fv,
                nlo, nhi, Oat + q0 * 512 + h * 64, qv, (u16*)smem);
    }
  }
}

__device__ __forceinline__ void phase_postmix(const Params& p) {
  char* ws = p.ws;
  const int lane = threadIdx.x & 63, wave = threadIdx.x >> 6;
  const u16* Prkv = (const u16*)(ws + OFF_PRKV);
  const u16* Aa = (const u16*)((const char*)p.out + SC_AA);
  const u16* Yb = (const u16*)((const char*)p.out + SC_YB);
  const u16* Oat = (const u16*)((const char*)p.out + SC_OAT);
  const u16* Gg = (const u16*)(ws + OFF_GG);
  u16* Ocat = (u16*)(ws + OFF_OCAT);
  const float* mu_shift = p.in[10];
  const float* k_a = p.in[17]; const float* r_k = p.in[18]; const float* gn_g = p.in[19]; const float* gn_b = p.in[20];
  const float* og = p.in[25];
  for (int m2 = blockIdx.x * 4 + wave; m2 < M2; m2 += gridDim.x * 4) {
    const bool prompt = m2 < 16384;
    const int m = prompt ? ((m2 >> 13) * LP + 16 + (m2 & 8191)) : (TP + m2 - 16384);
    const bool first = (!prompt) && (((m2 - 16384) & 15) == 0);
    const float* ss = p.in[5] + (size_t)(prompt ? 0 : ((m2 - 16384) >> 4)) * CR;
    const u16* row = Prkv + (size_t)m * NRKV;
#pragma unroll 4
    for (int h = 0; h < 8; ++h) {
      int col = h * 64 + lane;
      float y = bf2f(Yb[(size_t)m * 512 + col]);
      float mu = wave_sum(y) * (1.0f / 64.0f);
      float d = y - mu;
      float var = wave_sum(d * d) * (1.0f / 64.0f);
      float yn = d * rsqrtf(var + 64e-5f) * gn_g[col] + gn_b[col];
      const float r = bf2f(row[col]), k = bf2f(row[512 + col]), v = bf2f(row[1024 + col]);
      float a = bf2f(Aa[(size_t)m * 512 + col]);
      float kt = k * (1.0f + (a - 1.0f) * k_a[col]);
      float bs = wave_sum(r * kt * r_k[col]);
      float o = (yn + bs * v) * bf2f(Gg[(size_t)m * 512 + col]);
      Ocat[(size_t)m2 * 1024 + col] = f2bf(o);
    }
    float v[8]; float sq = 0.f;
#pragma unroll
    for (int i = 0; i < 8; ++i) { v[i] = bf2f(Oat[(size_t)m * 512 + lane + 64 * i]); sq += v[i] * v[i]; }
    float rs = rsqrtf(wave_sum(sq) * (1.0f / 512.0f) + 1e-6f);
#pragma unroll
    for (int i = 0; i < 8; ++i) Ocat[(size_t)m2 * 1024 + 512 + lane + 64 * i] = f2bf(v[i] * rs * og[lane + 64 * i]);
  }
}

__device__ __forceinline__ void phase_ln(const Params& p, const float* g, const float* b, u16* hb) {
  const int lane = threadIdx.x & 63, wave = threadIdx.x >> 6;
  const int stride = gridDim.x * 4;
  for (int m2 = blockIdx.x * 4 + wave; m2 < M2; m2 += 2 * stride) {
    const int mB = m2 + stride;
    const bool hasB = mB < M2;
    float* rowA = p.out + (size_t)m2 * 1024;
    float* rowB = p.out + (size_t)(hasB ? mB : m2) * 1024;
    float4 va[4], vb[4];
#pragma unroll
    for (int i = 0; i < 4; ++i) { va[i] = *(const float4*)(rowA + lane * 4 + 256 * i); vb[i] = *(const float4*)(rowB + lane * 4 + 256 * i); }
    float sa = 0.f, sb = 0.f;
#pragma unroll
    for (int i = 0; i < 4; ++i) { sa += va[i].x + va[i].y + va[i].z + va[i].w; sb += vb[i].x + vb[i].y + vb[i].z + vb[i].w; }
    const float muA = wave_sum(sa) * (1.0f / 1024.0f), muB = wave_sum(sb) * (1.0f / 1024.0f);
    float qa = 0.f, qb = 0.f;
#pragma unroll
    for (int i = 0; i < 4; ++i) {
      float a0 = va[i].x - muA, a1 = va[i].y - muA, a2 = va[i].z - muA, a3 = va[i].w - muA;
      float b0 = vb[i].x - muB, b1 = vb[i].y - muB, b2 = vb[i].z - muB, b3 = vb[i].w - muB;
      qa += a0 * a0 + a1 * a1 + a2 * a2 + a3 * a3;
      qb += b0 * b0 + b1 * b1 + b2 * b2 + b3 * b3;
    }
    const float rsA = rsqrtf(wave_sum(qa) * (1.0f / 1024.0f) + 1e-5f), rsB = rsqrtf(wave_sum(qb) * (1.0f / 1024.0f) + 1e-5f);
#pragma unroll
    for (int i = 0; i < 4; ++i) {
      int c = lane * 4 + 256 * i;
      float4 gg = *(const float4*)(g + c), b4 = *(const float4*)(b + c);
      float4 o;
      o.x = (va[i].x - muA) * rsA * gg.x + b4.x; o.y = (va[i].y - muA) * rsA * gg.y + b4.y;
      o.z = (va[i].z - muA) * rsA * gg.z + b4.z; o.w = (va[i].w - muA) * rsA * gg.w + b4.w;
      *(float4*)(rowA + c) = o;
      if (hb) { uint2 t; t.x = pack2(o.x, o.y); t.y = pack2(o.z, o.w); *(uint2*)(hb + (size_t)m2 * 1024 + c) = t; }
      if (hasB) {
        o.x = (vb[i].x - muB) * rsB * gg.x + b4.x; o.y = (vb[i].y - muB) * rsB * gg.y + b4.y;
        o.z = (vb[i].z - muB) * rsB * gg.z + b4.z; o.w = (vb[i].w - muB) * rsB * gg.w + b4.w;
        *(float4*)(rowB + c) = o;
        if (hb) { uint2 t; t.x = pack2(o.x, o.y); t.y = pack2(o.z, o.w); *(uint2*)(hb + (size_t)mB * 1024 + c) = t; }
      }
    }
  }
}

DI void fast_barrier(unsigned* word) {
  asm volatile("s_waitcnt vmcnt(0) lgkmcnt(0)" ::: "memory");
  __syncthreads();
  if (threadIdx.x == 0) {
    __builtin_amdgcn_fence(__ATOMIC_RELEASE, "agent");
    asm volatile("s_waitcnt vmcnt(0)" ::: "memory");
    __hip_atomic_fetch_add(word, 1u, __ATOMIC_RELAXED, __HIP_MEMORY_SCOPE_AGENT);
    const unsigned target = gridDim.x;
    unsigned spins = 0;
    while (__hip_atomic_load(word, __ATOMIC_RELAXED, __HIP_MEMORY_SCOPE_AGENT) < target) {
      __builtin_amdgcn_s_sleep(2);
      if (++spins > (1u << 24)) break;
    }
    __builtin_amdgcn_fence(__ATOMIC_ACQUIRE, "agent");
    asm volatile("s_waitcnt vmcnt(0)" ::: "memory");
  }
  __syncthreads();
}

#define XB_TMO      128
#define XB_XCNT(j)  (256  + 64 * (j))
#define XB_XSUB(j)  (1280 + 64 * (j))
#define XB_XGEN(j)  (2304 + 64 * (j))
#define XB_TOP      3328
#define XB_TOPGEN   3392
#define XB_SPIN_CAP (1u << 20)
DI unsigned xb_ld(unsigned* p) { return __hip_atomic_load(p, __ATOMIC_RELAXED, __HIP_MEMORY_SCOPE_AGENT); }
DI unsigned xb_add(unsigned* p, unsigned v) { return __hip_atomic_fetch_add(p, v, __ATOMIC_RELAXED, __HIP_MEMORY_SCOPE_AGENT); }
DI unsigned xb_xcc_id() { return (unsigned)__builtin_amdgcn_s_getreg((3 << 11) | 20) & 0xFu; }
#define XB_SPIN(cond, bar) do { unsigned _sp = 0; while (cond) { __builtin_amdgcn_s_sleep(1); \
    if ((++_sp & 255u) == 0u) { if (xb_ld(&(bar)[XB_TMO])) break; if (_sp > XB_SPIN_CAP) { atomicAdd(&(bar)[XB_TMO], 1u); break; } } } } while (0)
struct XcdBarrier { unsigned* bar; unsigned x; volatile unsigned* st; };
DI XcdBarrier xcd_barrier_post(unsigned* bar, volatile unsigned* st) {
  XcdBarrier b; b.bar = bar; b.x = xb_xcc_id(); b.st = st;
  if (threadIdx.x == 0) (void)xb_add(&bar[XB_XCNT(b.x)], 1u);
  return b;
}
DI void xcd_barrier_complete(unsigned* bar, unsigned x, unsigned& nloc, unsigned& nx) {
  const unsigned G = gridDim.x;
  unsigned sum, cnt, mine, sp = 0u;
  for (;;) {
    sum = 0u; cnt = 0u; mine = 0u;
#pragma unroll
    for (unsigned j = 0; j < 16; ++j) { const unsigned c = xb_ld(&bar[XB_XCNT(j)]); sum += c; cnt += (c > 0u) ? 1u : 0u; mine = (j == x) ? c : mine; }
    if (sum == G) break;
    __builtin_amdgcn_s_sleep(1);
    if ((++sp & 255u) == 0u) { if (xb_ld(&bar[XB_TMO])) break; if (sp > XB_SPIN_CAP) { atomicAdd(&bar[XB_TMO], 1u); break; } }
  }
  nloc = mine > 0u ? mine : 1u; nx = cnt > 0u ? cnt : 1u;
}
DI void xcd_barrier(const XcdBarrier& b) {
  asm volatile("s_waitcnt vmcnt(0)" ::: "memory");
  __syncthreads();
  if (threadIdx.x == 0) {
    unsigned* bar = b.bar;
    __builtin_amdgcn_s_waitcnt(0);
    unsigned nloc = b.st[0], nx = b.st[1];
    if (nloc == 0u) { xcd_barrier_complete(bar, b.x, nloc, nx); b.st[0] = nloc; b.st[1] = nx; }
    const unsigned old = xb_add(&bar[XB_XSUB(b.x)], 1u);
    const unsigned gen = old / nloc;
    if (old + 1u == (gen + 1u) * nloc) {
      __builtin_amdgcn_fence(__ATOMIC_RELEASE, "agent");
      asm volatile("s_waitcnt vmcnt(0)" ::: "memory");
      const unsigned og = xb_add(&bar[XB_TOP], 1u);
      const unsigned tg = og / nx;
      if (og + 1u == (tg + 1u) * nx) xb_add(&bar[XB_TOPGEN], 1u);
      else XB_SPIN(xb_ld(&bar[XB_TOPGEN]) == tg, bar);
      __builtin_amdgcn_fence(__ATOMIC_ACQUIRE, "agent");
      xb_add(&bar[XB_XGEN(b.x)], 1u);
      asm volatile("s_waitcnt vmcnt(0)" ::: "memory");
    } else {
      XB_SPIN(xb_ld(&bar[XB_XGEN(b.x)]) == gen, bar);
      __builtin_amdgcn_fence(__ATOMIC_ACQUIRE, "agent");
      asm volatile("s_waitcnt vmcnt(0)" ::: "memory");
    }
  }
  __syncthreads();
}

__global__ void __launch_bounds__(256, 2) fwd_megakernel(Params p) {
  __shared__ __attribute__((aligned(16))) char smem[SMEM_BYTES];
  cg::grid_group grid = cg::this_grid();
  char* ws = p.ws;
  unsigned* bar = (unsigned*)(ws + OFF_CNT);

#ifndef PHM
#define PHM 0xFFFF
#endif
  volatile unsigned* xst = (volatile unsigned*)(smem + 81472 + 16);
  if (threadIdx.x == 0) { xst[0] = 0u; xst[1] = 0u; }
  __syncthreads();
  const XcdBarrier xbar = xcd_barrier_post((unsigned*)(ws + OFF_XB), xst);
  if (PHM & 1) phase_prep(p, smem);
  if (p.ws == nullptr) grid.sync();
  xcd_barrier(xbar);
  if (PHM & 2) {
    EpiInproj e{(u16*)(ws + OFF_PRKV), (u16*)(ws + OFF_R6), p.out};
    constexpr int TM = (MT + 127) / 128, TN = (CIN + 127) / 128;
    gemm_phase((const u16*)(ws + OFF_R2), 1024, (const u16*)(ws + OFF_WIN), 1024, MT, CIN, 1024, TM * TN,
               [](int t, int& m0, int& n0) { m0 = (t / TN) * 128; n0 = (t % TN) * 128; }, e, (u16*)smem);
  }
  xcd_barrier(xbar);
  if (PHM & 4) phase_postproj(p);
  {
    ShiftSave sv;
    shift_save(p, sv);
    xcd_barrier(xbar);
    shift_apply(p, sv);
  }
  if (PHM & 8) phase_gemms3(p, (u16*)smem);
  xcd_barrier(xbar);
  if (PHM & 16) phase_mixers(p, smem);
  xcd_barrier(xbar);
  if (PHM & 32) phase_postmix(p);
  xcd_barrier(xbar);
  if (PHM & 64) {
    EpiOut e{p.in[0], p.in[1], (const float*)(ws + OFF_STATS), p.in[7], p.in[8], p.out};
    gemm_phase((const u16*)(ws + OFF_OCAT), 1024, (const u16*)(ws + OFF_WOUT), 1024, M2, 1024, 1024, 130 * 8,
               [](int t, int& m0, int& n0) { m0 = (t >> 3) * 128; n0 = (t & 7) * 128; }, e, (u16*)smem);
  }
  xcd_barrier(xbar);
  if (PHM & 128) phase_ln(p, p.in[27], p.in[28], (u16*)(ws + OFF_H1B));
  xcd_barrier(xbar);
  if (PHM & 256) {
    EpiUp e{(u16*)(ws + OFF_ACT)};
    gemm_phase((const u16*)(ws + OFF_H1B), 1024, (const u16*)(ws + OFF_WUP), 1024, M2, 4096, 1024, 130 * 32,
               [](int t, int& m0, int& n0) { m0 = (t >> 5) * 128; n0 = (t & 31) * 128; }, e, (u16*)smem);
  }
  xcd_barrier(xbar);
  if (PHM & 512) {
    EpiDown e{p.out};
    for (int t = blockIdx.x; t < 130 * 8; t += gridDim.x)
      gemm_tile((const u16*)(ws + OFF_ACT), 4096, (const u16*)(ws + OFF_WDOWN), 4096, M2, 1024, 4096, (t >> 3) * 128, (t & 7) * 128, e,
                (u16*)smem);
  }
  xcd_barrier(xbar);
  if (PHM & 1024) phase_ln(p, p.in[31], p.in[32], nullptr);
}

extern "C" void kernel_launch(void* const* d_in, const int* in_sizes, int n_in, void* d_out, int out_size, void* d_ws,
                              size_t ws_size, hipStream_t stream) {
  static int grid_blocks = 0;
  if (!grid_blocks) {
    int dev = 0, cus = 0, per_cu = 0;
    hipGetDevice(&dev);
    hipDeviceGetAttribute(&cus, hipDeviceAttributeMultiprocessorCount, dev);
    hipOccupancyMaxActiveBlocksPerMultiprocessor(&per_cu, (const void*)fwd_megakernel, 256, 0);
    if (per_cu > 2) per_cu = 2;
    if (per_cu < 1) per_cu = 1;
    grid_blocks = cus * per_cu;
  }
  Params p{};
  for (int i = 0; i < 33; ++i) p.in[i] = (const float*)d_in[i];
  p.out = (float*)d_out;
  p.ws = (char*)d_ws;
  hipMemsetAsync((char*)d_ws + OFF_CNT, 0, 8192, stream);
  hipMemsetAsync((char*)d_ws + OFF_XB, 0, 16384, stream);
  void* args[] = {&p};
  hipError_t e = hipLaunchCooperativeKernel((const void*)fwd_megakernel, dim3(grid_blocks), dim3(256), args, 0, stream);
  if (e != hipSuccess) fprintf(stderr, "cooperative launch failed: %s (grid %d)\n", hipGetErrorString(e), grid_blocks);
}
```

```cpp
#include <hip/hip_runtime.h>
#include <hip/hip_cooperative_groups.h>
#include <cstdio>
namespace cg = cooperative_groups;

typedef unsigned short u16;
typedef __attribute__((ext_vector_type(8))) short bf16x8;
typedef __attribute__((ext_vector_type(16))) float f32x16;
typedef __attribute__((ext_vector_type(2))) float f32x2;
typedef __attribute__((ext_vector_type(4))) unsigned u32x4;
typedef __attribute__((ext_vector_type(2))) unsigned u32x2;
typedef __attribute__((ext_vector_type(2))) __bf16 bf16x2_t;

#define DI __device__ __forceinline__
#define MFMA32(a, b, c) __builtin_amdgcn_mfma_f32_32x32x16_bf16((a), (b), (c), 0, 0, 0)

constexpr int D_ = 1024;
constexpr int LP = 8208;
constexpr int TP = 16416;
constexpr int TS = 256;
constexpr int MT = TP + TS;
constexpr int M2 = 16640;
constexpr int LKS = 2064;
constexpr int TKS = 16 * LKS;
constexpr int CR = 1792;
constexpr int CIN = 2464;
constexpr int NRKV = 1536;
constexpr int NREST = 928;
constexpr int LDVP = TP + 64;
constexpr int LDVS = TKS + 64;

constexpr size_t OFF_WIN = 0;
constexpr size_t OFF_WQB = OFF_WIN + (size_t)CIN * 1024 * 2;
constexpr size_t OFF_WKN = OFF_WQB + (size_t)768 * 384 * 2;
constexpr size_t OFF_WV = OFF_WKN + (size_t)512 * 256 * 2;
constexpr size_t OFF_WDEC = OFF_WV + (size_t)512 * 256 * 2;
constexpr size_t OFF_WAAA = OFF_WDEC + (size_t)512 * 64 * 2;
constexpr size_t OFF_WGATE = OFF_WAAA + (size_t)512 * 64 * 2;
constexpr size_t OFF_WOUT = OFF_WGATE + (size_t)512 * 128 * 2;
constexpr size_t OFF_WUP = OFF_WOUT + (size_t)1024 * 1024 * 2;
constexpr size_t OFF_WDOWN = OFF_WUP + (size_t)4096 * 1024 * 2;
constexpr size_t OFF_PRKV = OFF_WDOWN + (size_t)4096 * 1024 * 2;
constexpr size_t OFF_R2 = OFF_PRKV + (size_t)MT * NRKV * 2;
constexpr size_t OFF_GG = OFF_R2 + (size_t)MT * 1024 * 2;
constexpr size_t OFF_Q = OFF_GG + (size_t)MT * 512 * 2;
constexpr size_t OFF_KNP = OFF_Q + (size_t)MT * 768 * 2;
constexpr size_t OFF_VTP = OFF_KNP + (size_t)(TP + 64) * 512 * 2;
constexpr size_t OFF_R6 = OFF_VTP + (size_t)512 * LDVP * 2;
constexpr size_t OFF_VTS = OFF_R6 + (size_t)(TKS + 64) * 512 * 2;
constexpr size_t OFF_KRP = OFF_VTS + (size_t)512 * LDVS * 2;
constexpr size_t OFF_KRS = OFF_KRP + (size_t)(TP + 64) * 32 * 2;
constexpr size_t OFF_ROPE = OFF_KRS + (size_t)(TKS + 64) * 32 * 2;
constexpr size_t OFF_STATS = OFF_ROPE + (size_t)LP * 16 * 4 * 2;
constexpr size_t OFF_CNT = OFF_STATS + (size_t)MT * 2 * 4;
constexpr size_t OFF_PRE8 = OFF_CNT + 8192;
constexpr size_t OFF_XB = OFF_PRE8 + (size_t)MT * 8 * 4;
constexpr size_t WS_END = OFF_XB + 16384;
static_assert(WS_END < (size_t)256 * 1024 * 1024, "ws overflow");
constexpr size_t OFF_OCAT = OFF_R6;
constexpr size_t OFF_H1B = OFF_PRKV;
constexpr size_t OFF_ACT = OFF_R2;
static_assert(OFF_ACT + (size_t)M2 * 4096 * 2 < (size_t)256 * 1024 * 1024, "act overflow");
static_assert((size_t)M2 * 1024 * 2 <= (size_t)MT * NRKV * 2, "h1b overflow");

constexpr size_t SC_AA = 0;
constexpr size_t SC_LIN = SC_AA + (size_t)MT * 512 * 2;
constexpr size_t SC_QN = SC_LIN + (size_t)MT * 256 * 2;
constexpr size_t SC_CBP = SC_QN + (size_t)MT * 384 * 2;
constexpr size_t SC_CBS = SC_CBP + (size_t)TP * 256 * 2;
constexpr size_t SC_END = SC_CBS + (size_t)TKS * 256 * 2;
static_assert(SC_END <= (size_t)2 * 8192 * 1024 * 4, "scratch overflow");
constexpr size_t SC_YB = SC_LIN;
constexpr size_t SC_OAT = SC_CBP;
static_assert(SC_YB + (size_t)MT * 512 * 2 <= SC_CBP, "yb overflow");
static_assert(SC_OAT + (size_t)MT * 512 * 2 <= SC_END, "oat overflow");

constexpr size_t O_Y = 0;
constexpr size_t O_LATP = (size_t)M2 * 1024;
constexpr size_t O_ROPEP = O_LATP + (size_t)TP * 256;
constexpr size_t O_STATEP = O_ROPEP + (size_t)TP * 32;
constexpr size_t O_SHIFTP = O_STATEP + (size_t)2 * 8 * 64 * 64;
constexpr size_t O_LATS = O_SHIFTP + (size_t)2 * CR;
constexpr size_t O_ROPES = O_LATS + (size_t)TS * 256;
constexpr size_t O_STATES = O_ROPES + (size_t)TS * 32;
constexpr size_t O_SHIFTS = O_STATES + (size_t)16 * 8 * 64 * 64;

constexpr float ALPHA = 1.189207115002721f;
constexpr float DECAY_SCALE = 0.6065306597126334f;
constexpr float QSCALE = 0.10206207261596577f * 1.4426950408889634f;

constexpr int SMEM_BYTES = 81472 + 64;

struct Params {
  const float* in[33];
  float* out;
  char* ws;
};

DI u16 f2bf(float f) { unsigned u = __float_as_uint(f); u += 0x7FFFu + ((u >> 16) & 1u); return (u16)(u >> 16); }
DI float bf2f(u16 h) { return __uint_as_float(((unsigned)h) << 16); }
DI unsigned pack2(float a, float b) {
  f32x2 v = {a, b};
  bf16x2_t r = __builtin_convertvector(v, bf16x2_t);
  return __builtin_bit_cast(unsigned, r);
}
template <int CTRL> DI float dppf(float x) {
  return __int_as_float(__builtin_amdgcn_mov_dpp(__float_as_int(x), CTRL, 0xF, 0xF, true));
}
DI float allreduce16(float x) {
  x += dppf<0xB1>(x);
  x += dppf<0x4E>(x);
  x += dppf<0x141>(x);
  x += dppf<0x140>(x);
  return x;
}
DI float allreduce32(float x) {
  x = allreduce16(x);
  auto t = __builtin_amdgcn_permlane16_swap(__float_as_uint(x), __float_as_uint(x), false, false);
  return __uint_as_float(t[0]) + __uint_as_float(t[1]);
}
DI float wave_sum(float x) {
  x = allreduce32(x);
  auto t = __builtin_amdgcn_permlane32_swap(__float_as_uint(x), __float_as_uint(x), false, false);
  return __uint_as_float(t[0]) + __uint_as_float(t[1]);
}
DI float sigmoidf_(float x) { return 1.0f / (1.0f + __expf(-x)); }
DI float tanhf_(float x) { float e = __expf(2.0f * x); return 1.0f - 2.0f / (e + 1.0f); }

constexpr int GLD = 72;
constexpr int GBUF = 256 * GLD;
template <class Epi>
__device__ __forceinline__ void gemm_tile(const u16* __restrict__ A, int lda, const u16* __restrict__ Bt, int ldb,
                          int M, int N, int K, int m0, int n0, Epi& epi, u16* smem) {
  u16* As = smem;
  u16* Bs = smem + 128 * GLD;
  const int tid = threadIdx.x, lane = tid & 63, wave = tid >> 6;
  const int wm = wave >> 1, wn = wave & 1;
  const int r = lane & 31, hh = lane >> 5;
  size_t aoff[4], boff[4];
  int soff[4];
#pragma unroll
  for (int i = 0; i < 4; ++i) {
    int c = tid + 256 * i;
    int row = c >> 3, kc = c & 7;
    int ar = m0 + row; ar = ar < M ? ar : M - 1;
    int br = n0 + row; br = br < N ? br : N - 1;
    aoff[i] = (size_t)ar * lda + kc * 8;
    boff[i] = (size_t)br * ldb + kc * 8;
    soff[i] = row * GLD + kc * 8;
  }
  struct GRegs { u32x4 a[4], b[4]; };
  auto prefetch = [&](GRegs& R, int kt) {
#pragma unroll
    for (int i = 0; i < 4; ++i) {
      R.a[i] = *(const u32x4*)(A + aoff[i] + (size_t)kt * 64);
      R.b[i] = *(const u32x4*)(Bt + boff[i] + (size_t)kt * 64);
    }
  };
  auto lds_write = [&](const GRegs& R, int buf) {
#pragma unroll
    for (int i = 0; i < 4; ++i) {
      *(u32x4*)(As + buf * GBUF + soff[i]) = R.a[i];
      *(u32x4*)(Bs + buf * GBUF + soff[i]) = R.b[i];
    }
  };
  f32x16 acc[2][2];
#pragma unroll
  for (int i = 0; i < 2; ++i)
#pragma unroll
    for (int j = 0; j < 2; ++j)
#pragma unroll
      for (int e = 0; e < 16; ++e) acc[i][j][e] = 0.f;
  auto compute = [&](int buf) {
    const u16* Ab = As + buf * GBUF;
    const u16* Bb = Bs + buf * GBUF;
#pragma unroll
    for (int ks = 0; ks < 4; ++ks) {
      bf16x8 af[2], bfr[2];
#pragma unroll
      for (int i = 0; i < 2; ++i) {
        af[i] = *(const bf16x8*)(Ab + (wm * 64 + i * 32 + r) * GLD + ks * 16 + hh * 8);
        bfr[i] = *(const bf16x8*)(Bb + (wn * 64 + i * 32 + r) * GLD + ks * 16 + hh * 8);
      }
#pragma unroll
      for (int i = 0; i < 2; ++i)
#pragma unroll
        for (int j = 0; j < 2; ++j) acc[i][j] = MFMA32(af[i], bfr[j], acc[i][j]);
    }
  };
  const int nk = K >> 6;
  GRegs RA, RB;
  prefetch(RA, 0);
  if (1 < nk) prefetch(RB, 1);
  lds_write(RA, 0);
  __syncthreads();
  for (int kt = 0; kt < nk; kt += 2) {
    if (kt + 2 < nk) prefetch(RA, kt + 2);
    compute(0);
    if (kt + 1 < nk) lds_write(RB, 1);
    __syncthreads();
    if (kt + 1 < nk) {
      if (kt + 3 < nk) prefetch(RB, kt + 3);
      compute(1);
      if (kt + 2 < nk) lds_write(RA, 0);
      __syncthreads();
    }
  }
#pragma unroll
  for (int i = 0; i < 2; ++i)
#pragma unroll
    for (int j = 0; j < 2; ++j) {
      const int col = n0 + wn * 64 + j * 32 + r;
#pragma unroll
      for (int e = 0; e < 16; ++e) {
        const int row = m0 + wm * 64 + i * 32 + (e & 3) + 8 * (e >> 2) + 4 * hh;
        epi(row, col, acc[i][j][e], (row < M) && (col < N));
      }
    }
}

template <class Epi, class Map>
__device__ __forceinline__ void gemm_phase(const u16* __restrict__ A, int lda, const u16* __restrict__ Bt, int ldb,
                                           int M, int N, int K, int ntiles, Map tmap, Epi& epi, u16* smem) {
  u16* As = smem;
  u16* Bs = smem + 128 * GLD;
  const int tid = threadIdx.x, lane = tid & 63, wave = tid >> 6;
  const int wm = wave >> 1, wn = wave & 1;
  const int r = lane & 31, hh = lane >> 5;
  int t = blockIdx.x;
  if (t >= ntiles) return;
  size_t aoff[4], boff[4];
  int soff[4];
#pragma unroll
  for (int i = 0; i < 4; ++i) { int c = tid + 256 * i; soff[i] = (c >> 3) * GLD + (c & 7) * 8; }
  auto set_tile = [&](int m0, int n0) {
#pragma unroll
    for (int i = 0; i < 4; ++i) {
      int c = tid + 256 * i;
      int row = c >> 3, kc = c & 7;
      int ar = m0 + row; ar = ar < M ? ar : M - 1;
      int br = n0 + row; br = br < N ? br : N - 1;
      aoff[i] = (size_t)ar * lda + kc * 8;
      boff[i] = (size_t)br * ldb + kc * 8;
    }
  };
  struct GRegs { u32x4 a[4], b[4]; };
  auto prefetch = [&](GRegs& R, int kt) {
#pragma unroll
    for (int i = 0; i < 4; ++i) {
      R.a[i] = *(const u32x4*)(A + aoff[i] + (size_t)kt * 64);
      R.b[i] = *(const u32x4*)(Bt + boff[i] + (size_t)kt * 64);
    }
  };
  auto lds_write = [&](const GRegs& R, int buf) {
#pragma unroll
    for (int i = 0; i < 4; ++i) {
      *(u32x4*)(As + buf * GBUF + soff[i]) = R.a[i];
      *(u32x4*)(Bs + buf * GBUF + soff[i]) = R.b[i];
    }
  };
  const int nk = K >> 6;
  GRegs RA, RB;
  int m0, n0;
  tmap(t, m0, n0);
  set_tile(m0, n0);
  prefetch(RA, 0);
  prefetch(RB, 1);
  for (;;) {
    f32x16 acc[2][2];
#pragma unroll
    for (int i = 0; i < 2; ++i)
#pragma unroll
      for (int j = 0; j < 2; ++j)
#pragma unroll
        for (int e = 0; e < 16; ++e) acc[i][j][e] = 0.f;
    auto compute = [&](int buf) {
      const u16* Ab = As + buf * GBUF;
      const u16* Bb = Bs + buf * GBUF;
#pragma unroll
      for (int ks = 0; ks < 4; ++ks) {
        bf16x8 af[2], bfr[2];
#pragma unroll
        for (int i = 0; i < 2; ++i) {
          af[i] = *(const bf16x8*)(Ab + (wm * 64 + i * 32 + r) * GLD + ks * 16 + hh * 8);
          bfr[i] = *(const bf16x8*)(Bb + (wn * 64 + i * 32 + r) * GLD + ks * 16 + hh * 8);
        }
#pragma unroll
        for (int i = 0; i < 2; ++i)
#pragma unroll
          for (int j = 0; j < 2; ++j) acc[i][j] = MFMA32(af[i], bfr[j], acc[i][j]);
      }
    };
    lds_write(RA, 0);
    __syncthreads();
    for (int kt = 0; kt < nk; kt += 2) {
      if (kt + 2 < nk) prefetch(RA, kt + 2);
      compute(0);
      lds_write(RB, 1);
      __syncthreads();
      if (kt + 3 < nk) prefetch(RB, kt + 3);
      compute(1);
      if (kt + 2 < nk) lds_write(RA, 0);
      __syncthreads();
    }
    const int tn = t + (int)gridDim.x;
    const bool more = tn < ntiles;
    const int cm0 = m0, cn0 = n0;
    if (more) {
      tmap(tn, m0, n0);
      set_tile(m0, n0);
      prefetch(RA, 0);
    }
#pragma unroll
    for (int i = 0; i < 2; ++i)
#pragma unroll
      for (int j = 0; j < 2; ++j) {
        const int col = cn0 + wn * 64 + j * 32 + r;
#pragma unroll
        for (int e = 0; e < 16; ++e) {
          const int row = cm0 + wm * 64 + i * 32 + (e & 3) + 8 * (e >> 2) + 4 * hh;
          epi(row, col, acc[i][j][e], (row < M) && (col < N));
        }
      }
    if (!more) break;
    prefetch(RB, 1);
    t = tn;
  }
}

struct EpiInproj {
  u16* prkv; u16* prest; float* out;
  DI void operator()(int row, int col, float v, bool valid) const {
    if (!valid) return;
    if (col < NRKV) prkv[(size_t)row * NRKV + col] = f2bf(v);
    else prest[(size_t)row * NREST + (col - NRKV)] = f2bf(v);
    if (col < CR) {
      if (row < TP) {
        if (row == LP - 1) out[O_SHIFTP + col] = v;
        else if (row == 2 * LP - 1) out[O_SHIFTP + CR + col] = v;
      } else {
        int s = row - TP;
        if ((s & 15) == 15) out[O_SHIFTS + (size_t)(s >> 4) * CR + col] = v;
      }
    }
  }
};
struct EpiDecay {
  float* wd; const float* base;
  DI void operator()(int row, int col, float v, bool valid) const {
    if (valid) wd[(size_t)row * 512 + col] = __expf(-DECAY_SCALE * sigmoidf_(base[col] + v));
  }
};
struct EpiAaa {
  u16* aa; const float* base;
  DI void operator()(int row, int col, float v, bool valid) const {
    if (valid) aa[(size_t)row * 512 + col] = f2bf(sigmoidf_(base[col] + v));
  }
};
struct EpiStoreBf {
  u16* dst; int ld;
  DI void operator()(int row, int col, float v, bool valid) const {
    if (valid) dst[(size_t)row * ld + col] = f2bf(v);
  }
};
struct EpiQ {
  u16* q; const float* cosT; const float* sinT;
  DI void operator()(int row, int col, float v, bool valid) const {
    int dcol = col % 96;
    float partner = __shfl_xor(v, 16);
    if (dcol >= 64) {
      int rr = row < MT ? row : MT - 1;
      int pos = rr < TP ? (rr % LP) : 2048 + ((rr - TP) & 15);
      int i = (dcol - 64) & 15;
      float c = cosT[pos * 16 + i], s = sinT[pos * 16 + i];
      v = (dcol < 80) ? (v * c - partner * s) : (partner * s + v * c);
    }
    if (valid) q[(size_t)row * 768 + col] = f2bf(v * QSCALE);
  }
};
struct EpiOut {
  const float* x; const float* xs; const float* stats; const float* g; const float* b; float* out;
  DI void operator()(int row, int col, float v, bool valid) const {
    if (!valid) return;
    int m = row < 16384 ? ((row >> 13) * LP + 16 + (row & 8191)) : (TP + row - 16384);
    float mu = stats[2 * m], rs = stats[2 * m + 1];
    const float xv = row < 16384 ? x[(size_t)row * 1024 + col] : xs[(size_t)(row - 16384) * 1024 + col];
    float h = (xv - mu) * rs * g[col] + b[col];
    out[(size_t)row * 1024 + col] = ALPHA * h + v;
  }
};
struct EpiUp {
  u16* act;
  DI void operator()(int row, int col, float v, bool valid) const {
    if (valid) { float t = v > 0.f ? v : 0.f; act[(size_t)row * 4096 + col] = f2bf(t * t); }
  }
};
struct EpiDown {
  float* out;
  DI void operator()(int row, int col, float v, bool valid) const {
    if (valid) { size_t o = (size_t)row * 1024 + col; out[o] = ALPHA * out[o] + v; }
  }
};

__device__ __forceinline__ void transpose_tiles(const float* __restrict__ src, int ld_src, u16* __restrict__ dst, int K, int Nd, int mode,
                                float* tl) {
  const int tid = threadIdx.x, tx = tid & 31, ty = tid >> 5;
  const int ntn = Nd >> 5, ntk = K >> 5;
  for (int t = blockIdx.x; t < ntn * ntk; t += gridDim.x) {
    int tn = t % ntn, tk = t / ntn;
    int n0 = tn * 32, k0 = tk * 32;
    int n = n0 + tx;
    int sc = mode == 0 ? n : ((n >> 6) * 128 + (n & 63) + (mode == 2 ? 64 : 0));
#pragma unroll
    for (int i = 0; i < 4; ++i) {
      int k = k0 + ty + 8 * i;
      tl[(ty + 8 * i) * 33 + tx] = src[(size_t)k * ld_src + sc];
    }
    __syncthreads();
#pragma unroll
    for (int i = 0; i < 4; ++i) {
      int nn = ty + 8 * i;
      dst[(size_t)(n0 + nn) * K + k0 + tx] = f2bf(tl[tx * 33 + nn]);
    }
    __syncthreads();
  }
}

__device__ __forceinline__ void phase_prep(const Params& p, char* smem) {
  char* ws = p.ws;
  float* tl = (float*)smem;
  transpose_tiles(p.in[9], CIN, (u16*)(ws + OFF_WIN), 1024, CIN, 0, tl);
  transpose_tiles(p.in[22], 768, (u16*)(ws + OFF_WQB), 384, 768, 0, tl);
  transpose_tiles(p.in[24], 1024, (u16*)(ws + OFF_WKN), 256, 512, 1, tl);
  transpose_tiles(p.in[24], 1024, (u16*)(ws + OFF_WV), 256, 512, 2, tl);
  transpose_tiles(p.in[11], 512, (u16*)(ws + OFF_WDEC), 64, 512, 0, tl);
  transpose_tiles(p.in[13], 512, (u16*)(ws + OFF_WAAA), 64, 512, 0, tl);
  transpose_tiles(p.in[15], 512, (u16*)(ws + OFF_WGATE), 128, 512, 0, tl);
  transpose_tiles(p.in[26], 1024, (u16*)(ws + OFF_WOUT), 1024, 1024, 0, tl);
  transpose_tiles(p.in[29], 4096, (u16*)(ws + OFF_WUP), 1024, 4096, 0, tl);
  transpose_tiles(p.in[30], 1024, (u16*)(ws + OFF_WDOWN), 4096, 1024, 0, tl);

  const int tid = threadIdx.x, lane = tid & 63, wave = tid >> 6;
  {
    u16* Hb = (u16*)(ws + OFF_R2);
    float* stats = (float*)(ws + OFF_STATS);
    const float* g = p.in[7]; const float* bb = p.in[8];
    auto rowsrc = [&](int m) -> const float* {
      if (m < TP) { int b = m / LP, l = m % LP; return l < 16 ? p.in[6] + (size_t)l * 1024 : p.in[0] + ((size_t)b * 8192 + (l - 16)) * 1024; }
      return p.in[1] + (size_t)(m - TP) * 1024;
    };
    const int stride = gridDim.x * 4;
    int m = blockIdx.x * 4 + wave;
    float4 v[4], vn[4];
    if (m < MT) {
      const float* src = rowsrc(m);
#pragma unroll
      for (int i = 0; i < 4; ++i) v[i] = *(const float4*)(src + lane * 4 + 256 * i);
    }
    for (; m < MT; m += stride) {
      const int mn = m + stride;
      {
        const float* srcn = rowsrc(mn < MT ? mn : m);
#pragma unroll
        for (int i = 0; i < 4; ++i) vn[i] = *(const float4*)(srcn + lane * 4 + 256 * i);
      }
      float s = 0.f;
#pragma unroll
      for (int i = 0; i < 4; ++i) s += v[i].x + v[i].y + v[i].z + v[i].w;
      float mu = wave_sum(s) * (1.0f / 1024.0f);
      float q = 0.f;
#pragma unroll
      for (int i = 0; i < 4; ++i) { float a = v[i].x - mu, b2 = v[i].y - mu, c = v[i].z - mu, d = v[i].w - mu; q += a * a + b2 * b2 + c * c + d * d; }
      float rs = rsqrtf(wave_sum(q) * (1.0f / 1024.0f) + 1e-5f);
      if (lane == 0) { stats[2 * m] = mu; stats[2 * m + 1] = rs; }
#pragma unroll
      for (int i = 0; i < 4; ++i) {
        int c = lane * 4 + 256 * i;
        float4 gg = *(const float4*)(g + c), b4 = *(const float4*)(bb + c);
        uint2 o;
        o.x = pack2((v[i].x - mu) * rs * gg.x + b4.x, (v[i].y - mu) * rs * gg.y + b4.y);
        o.y = pack2((v[i].z - mu) * rs * gg.z + b4.z, (v[i].w - mu) * rs * gg.w + b4.w);
        *(uint2*)(Hb + (size_t)m * 1024 + c) = o;
      }
#pragma unroll
      for (int i = 0; i < 4; ++i) v[i] = vn[i];
    }
  }
  const size_t gtid = (size_t)blockIdx.x * 256 + tid, gsz = (size_t)gridDim.x * 256;
  {
    float* cosT = (float*)(ws + OFF_ROPE); float* sinT = cosT + LP * 16;
    for (size_t e = gtid; e < (size_t)LP * 16; e += gsz) {
      int pos = (int)(e >> 4), i = (int)(e & 15);
      double inv = exp(-(double)(2 * i) / 32.0 * 9.210340371976184);
      double rev = (double)pos * inv * 0.15915494309189535;
      rev -= rint(rev);
      float rf = (float)rev;
      cosT[e] = __builtin_amdgcn_cosf(rf);
      sinT[e] = __builtin_amdgcn_sinf(rf);
    }
  }
  {
    u16* CbS = (u16*)((char*)p.out + SC_CBS);
    const float* cl = p.in[2];
    for (size_t e0 = gtid; e0 < (size_t)16 * 2048 * 64; e0 += 4 * gsz) {
      float4 v[4]; size_t ee[4];
#pragma unroll
      for (int u = 0; u < 4; ++u) {
        ee[u] = e0 + u * gsz; if (ee[u] >= (size_t)16 * 2048 * 64) ee[u] = e0;
        v[u] = *(const float4*)(cl + (ee[u] >> 6) * 256 + (ee[u] & 63) * 4);
      }
#pragma unroll
      for (int u = 0; u < 4; ++u) {
        size_t row = ee[u] >> 6; int c4 = (int)(ee[u] & 63);
        int b = (int)(row >> 11), key = (int)(row & 2047);
        uint2 o; o.x = pack2(v[u].x, v[u].y); o.y = pack2(v[u].z, v[u].w);
        *(uint2*)(CbS + ((size_t)b * LKS + key) * 256 + c4 * 4) = o;
      }
    }
    u16* KRs = (u16*)(ws + OFF_KRS);
    const float* cr = p.in[3];
    for (size_t e = gtid; e < (size_t)16 * 2048 * 8; e += gsz) {
      size_t row = e >> 3; int c4 = (int)(e & 7);
      int b = (int)(row >> 11), key = (int)(row & 2047);
      float4 v = *(const float4*)(cr + row * 32 + c4 * 4);
      uint2 o; o.x = pack2(v.x, v.y); o.y = pack2(v.z, v.w);
      *(uint2*)(KRs + ((size_t)b * LKS + key) * 32 + c4 * 4) = o;
    }
  }
}

__device__ __forceinline__ void phase_postproj(const Params& p) {
  char* ws = p.ws;
  const int lane = threadIdx.x & 63, wave = threadIdx.x >> 6;
  const u16* Prest = (const u16*)(ws + OFF_R6);
  u16* Lin = (u16*)((char*)p.out + SC_LIN);
  u16* Qn = (u16*)((char*)p.out + SC_QN);
  u16* CbP = (u16*)((char*)p.out + SC_CBP);
  u16* CbS = (u16*)((char*)p.out + SC_CBS);
  u16* KRp = (u16*)(ws + OFF_KRP);
  u16* KRs = (u16*)(ws + OFF_KRS);
  const float* cosT = (const float*)(ws + OFF_ROPE); const float* sinT = cosT + LP * 16;
  const float* mu_shift = p.in[10];
  const float* sshift = p.in[5];
  const float* qg = p.in[21]; const float* kvg = p.in[23];
  for (int m = blockIdx.x * 4 + wave; m < MT; m += gridDim.x * 4) {
    const bool prompt = m < TP;
    int b, l;
    if (prompt) { b = m / LP; l = m % LP; } else { b = (m - TP) >> 4; l = (m - TP) & 15; }
    const u16* row = Prest + (size_t)m * NREST;
#pragma unroll
    for (int i = 0; i < 4; ++i) {
      int c = lane + 64 * i;
      float cur = bf2f(row[c]);
      float prev;
      if (l > 0) prev = bf2f(row[c - NREST]);
      else prev = prompt ? 0.f : sshift[(size_t)b * CR + NRKV + c];
      float x = cur + mu_shift[NRKV + c] * (prev - cur);
      float o = i == 0 ? tanhf_(x) : (i == 1 ? x : sigmoidf_(x));
      Lin[(size_t)m * 256 + c] = f2bf(o);
    }
    {
      float v[6]; float ss = 0.f;
#pragma unroll
      for (int i = 0; i < 6; ++i) { v[i] = bf2f(row[256 + lane + 64 * i]); ss += v[i] * v[i]; }
      float rs = rsqrtf(wave_sum(ss) * (1.0f / 384.0f) + 1e-6f);
#pragma unroll
      for (int i = 0; i < 6; ++i) Qn[(size_t)m * 384 + lane + 64 * i] = f2bf(v[i] * rs * qg[lane + 64 * i]);
    }
    {
      float v[4]; float ss = 0.f;
#pragma unroll
      for (int i = 0; i < 4; ++i) { v[i] = bf2f(row[640 + lane + 64 * i]); ss += v[i] * v[i]; }
      float rs = rsqrtf(wave_sum(ss) * (1.0f / 256.0f) + 1e-6f);
      float* lo = prompt ? p.out + O_LATP + (size_t)m * 256 : p.out + O_LATS + (size_t)(m - TP) * 256;
      u16* cb = prompt ? CbP + (size_t)m * 256 : CbS + ((size_t)b * LKS + 2048 + l) * 256;
#pragma unroll
      for (int i = 0; i < 4; ++i) {
        float c = v[i] * rs * kvg[lane + 64 * i];
        lo[lane + 64 * i] = c;
        cb[lane + 64 * i] = f2bf(c);
      }
    }
    {
      int i = lane & 15;
      float x1 = bf2f(row[896 + i]), x2 = bf2f(row[912 + i]);
      int pos = prompt ? l : 2048 + l;
      float c = cosT[pos * 16 + i], s = sinT[pos * 16 + i];
      float o1 = x1 * c - x2 * s, o2 = x1 * s + x2 * c;
      float* ro = prompt ? p.out + O_ROPEP + (size_t)m * 32 : p.out + O_ROPES + (size_t)(m - TP) * 32;
      u16* kr = prompt ? KRp + (size_t)m * 32 : KRs + ((size_t)b * LKS + 2048 + l) * 32;
      if (lane < 16) { ro[i] = o1; ro[16 + i] = o2; kr[i] = f2bf(o1); kr[16 + i] = f2bf(o2); }
    }
  }
}

struct ShiftSave { unsigned d[12]; };
__device__ __forceinline__ void shift_save(const Params& p, ShiftSave& sv) {
  const int lane = threadIdx.x & 63, wave = threadIdx.x >> 6;
  const int tpw = (MT + (int)gridDim.x * 4 - 1) / ((int)gridDim.x * 4);
  const int m_lo = (blockIdx.x * 4 + wave) * tpw;
  const unsigned* Pd = (const unsigned*)(p.ws + OFF_PRKV);
  const int mr = (m_lo > 0 && m_lo < MT) ? m_lo - 1 : 0;
#pragma unroll
  for (int i = 0; i < 12; ++i) sv.d[i] = Pd[(size_t)mr * (NRKV / 2) + lane + 64 * i];
}
__device__ __forceinline__ void shift_apply(const Params& p, const ShiftSave& sv) {
  const int lane = threadIdx.x & 63, wave = threadIdx.x >> 6;
  const int tpw = (MT + (int)gridDim.x * 4 - 1) / ((int)gridDim.x * 4);
  const int m_lo = (blockIdx.x * 4 + wave) * tpw;
  if (m_lo >= MT) return;
  const int m_hi = (m_lo + tpw < MT) ? m_lo + tpw : MT;
  unsigned* Pd = (unsigned*)(p.ws + OFF_PRKV);
  float* PRE8 = (float*)(p.ws + OFF_PRE8);
  const float* mu = p.in[10];
  const float* k_k = p.in[16];
  for (int m = m_hi - 1; m >= m_lo; --m) {
    const bool prompt = m < TP;
    int b, l;
    if (prompt) { b = m / LP; l = m % LP; } else { b = (m - TP) >> 4; l = (m - TP) & 15; }
    unsigned* row = Pd + (size_t)m * (NRKV / 2);
    unsigned cur[12], prv[12];
#pragma unroll
    for (int i = 0; i < 12; ++i) cur[i] = row[lane + 64 * i];
    if (l > 0 && m > m_lo) {
#pragma unroll
      for (int i = 0; i < 12; ++i) prv[i] = row[lane + 64 * i - NRKV / 2];
    } else {
#pragma unroll
      for (int i = 0; i < 12; ++i) prv[i] = sv.d[i];
    }
#pragma unroll
    for (int i = 0; i < 12; ++i) {
      const int c = 2 * (lane + 64 * i);
      float c0 = __uint_as_float(cur[i] << 16), c1 = __uint_as_float(cur[i] & 0xFFFF0000u);
      float p0 = __uint_as_float(prv[i] << 16), p1 = __uint_as_float(prv[i] & 0xFFFF0000u);
      if (l == 0) {
        if (prompt) { p0 = 0.f; p1 = 0.f; }
        else { const float2 q = *(const float2*)(p.in[5] + (size_t)b * CR + c); p0 = q.x; p1 = q.y; }
      }
      const float2 mm = *(const float2*)(mu + c);
      const float o0 = c0 + mm.x * (p0 - c0), o1 = c1 + mm.y * (p1 - c1);
      row[lane + 64 * i] = pack2(o0, o1);
      if (i >= 4 && i < 8) {
        const float2 kw = *(const float2*)(k_k + c - 512);
        const float q0 = o0 * kw.x, q1 = o1 * kw.y;
        const float ss = allreduce32(fmaf(q0, q0, q1 * q1));
        if ((lane & 31) == 0) PRE8[(size_t)m * 8 + 2 * (i - 4) + (lane >> 5)] = __builtin_amdgcn_rsqf(fmaxf(ss, 1e-24f));
      }
    }
  }
}

__device__ __forceinline__ void phase_gemms3(const Params& p, u16* smem) {
  char* ws = p.ws;
  const u16* Lin = (const u16*)((char*)p.out + SC_LIN);
  const u16* Qn = (const u16*)((char*)p.out + SC_QN);
  const u16* CbP = (const u16*)((char*)p.out + SC_CBP);
  const u16* CbS = (const u16*)((char*)p.out + SC_CBS);
  constexpr int TM = (MT + 127) / 128;
  constexpr int TMP = (TP + 127) / 128;
  constexpr int TMS = TKS / 128;
  constexpr int J0 = TM * 4, J1 = J0 + TM * 4, J2 = J1 + TM * 4, J3 = J2 + TM * 6, J4 = J3 + TMP * 4, J5 = J4 + TMP * 4,
                J6 = J5 + TMS * 4, J7 = J6 + TMS * 4;
  for (int t = blockIdx.x; t < J7; t += gridDim.x) {
    if (t < J0) {
      EpiDecay e{(float*)(ws + OFF_R2), p.in[12]};
      gemm_tile(Lin, 256, (const u16*)(ws + OFF_WDEC), 64, MT, 512, 64, (t >> 2) * 128, (t & 3) * 128, e, smem);
    } else if (t < J1) {
      int u = t - J0;
      EpiAaa e{(u16*)((char*)p.out + SC_AA), p.in[14]};
      gemm_tile(Lin + 64, 256, (const u16*)(ws + OFF_WAAA), 64, MT, 512, 64, (u >> 2) * 128, (u & 3) * 128, e, smem);
    } else if (t < J2) {
      int u = t - J1;
      EpiStoreBf e{(u16*)(ws + OFF_GG), 512};
      gemm_tile(Lin + 128, 256, (const u16*)(ws + OFF_WGATE), 128, MT, 512, 128, (u >> 2) * 128, (u & 3) * 128, e, smem);
    } else if (t < J3) {
      int u = t - J2;
      EpiQ e{(u16*)(ws + OFF_Q), (const float*)(ws + OFF_ROPE), (const float*)(ws + OFF_ROPE) + LP * 16};
      gemm_tile(Qn, 384, (const u16*)(ws + OFF_WQB), 384, MT, 768, 384, (u / 6) * 128, (u % 6) * 128, e, smem);
    } else if (t < J4) {
      int u = t - J3;
      EpiStoreBf e{(u16*)(ws + OFF_KNP), 512};
      gemm_tile(CbP, 256, (const u16*)(ws + OFF_WKN), 256, TP, 512, 256, (u >> 2) * 128, (u & 3) * 128, e, smem);
    } else if (t < J5) {
      int u = t - J4;
      EpiStoreBf e{(u16*)(ws + OFF_VTP), LDVP};
      gemm_tile((const u16*)(ws + OFF_WV), 256, CbP, 256, 512, TP, 256, (u & 3) * 128, (u >> 2) * 128, e, smem);
    } else if (t < J6) {
      int u = t - J5;
      EpiStoreBf e{(u16*)(ws + OFF_R6), 512};
      gemm_tile(CbS, 256, (const u16*)(ws + OFF_WKN), 256, TKS, 512, 256, (u >> 2) * 128, (u & 3) * 128, e, smem);
    } else {
      int u = t - J6;
      EpiStoreBf e{(u16*)(ws + OFF_VTS), LDVS};
      gemm_tile((const u16*)(ws + OFF_WV), 256, CbS, 256, 512, TKS, 256, (u & 3) * 128, (u >> 2) * 128, e, smem);
    }
  }
}

constexpr int SB_A4 = 0, SB_B4 = 2816, SB_VV = 5632, SB_SIZE = 5712;
constexpr int SB_YP = 2 * SB_SIZE, SB_YPSZ = 64 * 36;
DI float afma(float a, float b, float c) { float r; asm("v_fma_f32 %0, %1, %2, %3" : "=v"(r) : "v"(a), "v"(b), "v"(c)); return r; }
DI float amul(float a, float b) { float r; asm("v_mul_f32 %0, %1, %2" : "=v"(r) : "v"(a), "v"(b)); return r; }
DI void lds_barrier() { asm volatile("s_waitcnt lgkmcnt(0)\n\ts_barrier" ::: "memory"); }
DI float bflo(unsigned u) { return __uint_as_float(u << 16); }
DI float bfhi(unsigned u) { return __uint_as_float(u & 0xFFFF0000u); }
struct ScanRaw { unsigned rs[4], ks[4], av[4]; float2 wv[4]; float inv[4]; float vs; };
__device__ __forceinline__ void scan_item(const Params& p, bool prompt, int b, int h, int grp, float* smem) {
  char* ws = p.ws;
  const int tid = threadIdx.x, lane = tid & 63, wave = tid >> 6;
  const u16* Prkv = (const u16*)(ws + OFF_PRKV);
  const float* Wd = (const float*)(ws + OFF_R2);
  const u16* Aa = (const u16*)((const char*)p.out + SC_AA);
  u16* Yb = (u16*)((char*)p.out + SC_YB);
  const int L = prompt ? LP : 16;
  const int nchunks = L / 16;
  const size_t mbase = prompt ? (size_t)b * LP : (size_t)TP + b * 16;
  const int c2 = lane & 31, ts = lane >> 5;

  if (wave < 2) {
    const int row4 = wave * 2 + ts;
    const int irow = grp * 4 + row4;
    const size_t sidx = (((size_t)b * 8 + h) * 64 + irow) * 64 + c2 * 2;
    float s0 = 0.f, s1 = 0.f;
    if (!prompt) { float2 t = *(const float2*)(p.in[4] + sidx); s0 = t.x; s1 = t.y; }
    lds_barrier();
    for (int c = 0; c < nchunks; ++c) {
      const float* pa = smem + (c & 1) * SB_SIZE + SB_A4 + c2 * 4;
      const float* pb = smem + (c & 1) * SB_SIZE + SB_B4 + c2 * 4;
      const float* pv = smem + (c & 1) * SB_SIZE + SB_VV + row4 * 20;
      float* py = smem + SB_YP + (c & 1) * SB_YPSZ + row4 * 36 + c2;
      float4 Aq[6], Bq[6];
      float4 Vc = *(const float4*)(pv), Vn = *(const float4*)(pv + 4);
#pragma unroll
      for (int i = 0; i < 6; ++i) {
        Aq[i] = *(const float4*)(pa + i * 128); Bq[i] = *(const float4*)(pb + i * 128);
      }
#pragma unroll
      for (int t = 0; t < 16; ++t) {
        const int sl = t % 6, vl = t & 3;
        if (vl == 0 && t > 0) { Vc = Vn; Vn = *(const float4*)(pv + t + 4); }
        const float4 A0 = Aq[sl], B0 = Bq[sl];
        const float v0 = vl == 0 ? Vc.x : (vl == 1 ? Vc.y : (vl == 2 ? Vc.z : Vc.w));
        Aq[sl] = *(const float4*)(pa + (t + 6) * 128); Bq[sl] = *(const float4*)(pb + (t + 6) * 128);
        const float a0 = bflo(__float_as_uint(A0.z)), a1 = bfhi(__float_as_uint(A0.z));
        const float2 R0 = make_float2(bflo(__float_as_uint(A0.w)), bfhi(__float_as_uint(A0.w)));
        float sa = amul(s0, a0) + amul(s1, a1);
        const float d0 = afma(v0, B0.z, amul(s0, A0.x)), d1 = afma(v0, B0.w, amul(s1, A0.y));
        sa = allreduce32(sa);
        s0 = afma(sa, B0.x, d0); s1 = afma(sa, B0.y, d1);
        py[t * 144] = amul(s0, R0.x) + amul(s1, R0.y);
      }
      lds_barrier();
    }
    float* so = p.out + (prompt ? O_STATEP : O_STATES) + sidx;
    *(float2*)so = make_float2(s0, s1);
  } else {
    const int ubeg = wave == 2 ? 0 : 4;
    const int hc = h * 64 + 2 * c2;
    const float2 kkw = *(const float2*)(p.in[16] + hc), kaw = *(const float2*)(p.in[17] + hc);
    const int vr4 = lane & 3, vtt = lane >> 2;
    const int vcol = h * 64 + grp * 4 + vr4;
    const float* PRE8 = (const float*)(ws + OFF_PRE8);
    auto prefetch = [&](ScanRaw& R, int chunk) {
      chunk = chunk < nchunks ? chunk : nchunks - 1;
      const int t0 = chunk * 16;
#pragma unroll
      for (int i = 0; i < 4; ++i) {
        const size_t m = mbase + t0 + 2 * (ubeg + i) + ts;
        const u16* row = Prkv + m * NRKV;
        R.rs[i] = *(const unsigned*)(row + hc); R.ks[i] = *(const unsigned*)(row + 512 + hc);
        R.wv[i] = *(const float2*)(Wd + m * 512 + hc);
        R.av[i] = *(const unsigned*)(Aa + m * 512 + hc);
        R.inv[i] = PRE8[m * 8 + h];
      }
      R.vs = bf2f(Prkv[(mbase + t0 + vtt) * NRKV + 1024 + vcol]);
    };
    auto stage = [&](const ScanRaw& R, float* buf) {
#pragma unroll
      for (int i = 0; i < 4; ++i) {
        const int tt = 2 * (ubeg + i) + ts;
        const float r0 = bflo(R.rs[i]), r1 = bfhi(R.rs[i]);
        const float k0 = bflo(R.ks[i]), k1 = bfhi(R.ks[i]);
        const float a0 = bflo(R.av[i]), a1 = bfhi(R.av[i]);
        const float kk0 = k0 * kkw.x * R.inv[i], kk1 = k1 * kkw.y * R.inv[i];
        const float kt0 = k0 * (1.0f + (a0 - 1.0f) * kaw.x), kt1 = k1 * (1.0f + (a1 - 1.0f) * kaw.y);
        *(float4*)(buf + SB_A4 + (tt * 32 + c2) * 4) = make_float4(R.wv[i].x, R.wv[i].y, __uint_as_float(pack2(-kk0, -kk1)), __uint_as_float(R.rs[i]));
        *(float4*)(buf + SB_B4 + (tt * 32 + c2) * 4) = make_float4(kk0 * a0, kk1 * a1, kt0, kt1);
      }
      if (wave == 3) buf[SB_VV + vr4 * 20 + vtt] = R.vs;
    };
    auto yflush = [&](int chunk) {
      chunk = chunk < 0 ? 0 : chunk;
      const float4* yp = (const float4*)(smem + SB_YP + (chunk & 1) * SB_YPSZ + lane * 36);
      float4 acc = yp[0];
#pragma unroll
      for (int i = 1; i < 8; ++i) { const float4 q = yp[i]; acc.x += q.x; acc.y += q.y; acc.z += q.z; acc.w += q.w; }
      const float y = (acc.x + acc.y) + (acc.z + acc.w);
      Yb[(mbase + chunk * 16 + vtt) * 512 + vcol] = f2bf(y);
    };
    ScanRaw S0, S1;
    prefetch(S0, 0);
    prefetch(S1, 1);
    stage(S0, smem);
    prefetch(S0, 2);
    lds_barrier();
    int c = 0;
    for (; c + 1 < nchunks; c += 2) {
      stage(S1, smem + SB_SIZE);
      prefetch(S1, c + 3);
      if (wave == 2) yflush(c - 1);
      lds_barrier();
      stage(S0, smem);
      prefetch(S0, c + 4);
      if (wave == 2) yflush(c);
      lds_barrier();
    }
    if (wave == 2) yflush(c - 1);
    lds_barrier();
    if (wave == 2) yflush(nchunks - 1);
  }
  __syncthreads();
}

constexpr int KLD = 104;
constexpr int VLD = 68;
constexpr int ATT_BUF = 64 * KLD + 64 * VLD;
__device__ __forceinline__ void attn_item(const u16* __restrict__ Q, int qrow_lim, const u16* __restrict__ Kn, const u16* __restrict__ KR,
                          const u16* __restrict__ Vt, int ldv, int first_valid, int nk_lo, int nk_hi, u16* __restrict__ O,
                          int q_valid, u16* smem) {
  u16* Ks = smem;
  u16* Vs = smem + 64 * KLD;
  const int tid = threadIdx.x, lane = tid & 63, wave = tid >> 6;
  const int r = lane & 31, hh = lane >> 5;
  const int my_nk = wave < 2 ? nk_lo : nk_hi;
  auto ntiles = [&](int nk) { return nk <= first_valid ? 1 : 1 + (nk - first_valid + 63) / 64; };
  const int nt_all = ntiles(nk_hi);
  const int my_nt = (wave * 32 < q_valid) ? ntiles(my_nk) : 0;
  bf16x8 qf[6];
  {
    int qr = wave * 32 + r; qr = qr < qrow_lim ? qr : qrow_lim - 1;
    const u16* qp = Q + (size_t)qr * 768 + hh * 8;
#pragma unroll
    for (int ks = 0; ks < 6; ++ks) qf[ks] = *(const bf16x8*)(qp + ks * 16);
  }
  int kkey[3], kch[3];
#pragma unroll
  for (int i = 0; i < 3; ++i) { int id = tid + 256 * i; kkey[i] = id / 12; kch[i] = id % 12; }
  struct KVRegs { u32x4 rk[3]; u32x4 rv[2]; };
  auto prefetch = [&](KVRegs& R, int kt) {
    int start = kt == 0 ? 0 : first_valid + 64 * (kt - 1);
#pragma unroll
    for (int i = 0; i < 3; ++i) {
      size_t key = (size_t)(start + kkey[i]);
      const u16* src = kch[i] < 8 ? Kn + key * 512 + kch[i] * 8 : KR + key * 32 + (kch[i] - 8) * 8;
      R.rk[i] = *(const u32x4*)src;
    }
#pragma unroll
    for (int i = 0; i < 2; ++i) {
      int id = tid + 256 * i; int d = id >> 3, ch = id & 7;
      R.rv[i] = *(const u32x4*)(Vt + (size_t)d * ldv + start + ch * 8);
    }
  };
  auto lds_write = [&](const KVRegs& R, int buf) {
    u16* Kb = Ks + buf * ATT_BUF;
    u16* Vb = Vs + buf * ATT_BUF;
#pragma unroll
    for (int i = 0; i < 3; ++i) *(u32x4*)(Kb + kkey[i] * KLD + kch[i] * 8) = R.rk[i];
#pragma unroll
    for (int i = 0; i < 2; ++i) {
      int id = tid + 256 * i; int d = id >> 3, ch = id & 7;
      u32x2* dst = (u32x2*)(Vb + d * VLD + ch * 8);
      u32x2 t0 = {R.rv[i].x, R.rv[i].y}, t1 = {R.rv[i].z, R.rv[i].w};
      dst[0] = t0;
      dst[1] = t1;
    }
  };
  f32x16 o[2];
#pragma unroll
  for (int i = 0; i < 2; ++i)
#pragma unroll
    for (int e = 0; e < 16; ++e) o[i][e] = 0.f;
  float m_run = -1e30f, l_run = 0.f;
  auto compute = [&](int kt) {
    const u16* Kb = Ks + (kt & 1) * ATT_BUF;
    const u16* Vb = Vs + (kt & 1) * ATT_BUF;
    const int start = kt == 0 ? 0 : first_valid + 64 * (kt - 1);
    int tv = kt == 0 ? first_valid : 64;
    if (my_nk - start < tv) tv = my_nk - start;
    f32x16 s[2];
#pragma unroll
    for (int T = 0; T < 2; ++T)
#pragma unroll
      for (int e = 0; e < 16; ++e) s[T][e] = 0.f;
#pragma unroll
    for (int ks = 0; ks < 6; ++ks) {
#pragma unroll
      for (int T = 0; T < 2; ++T) {
        bf16x8 kf = *(const bf16x8*)(Kb + (T * 32 + r) * KLD + ks * 16 + hh * 8);
        s[T] = MFMA32(kf, qf[ks], s[T]);
      }
    }
    if (tv < 64) {
#pragma unroll
      for (int T = 0; T < 2; ++T)
#pragma unroll
        for (int e = 0; e < 16; ++e) {
          int kidx = T * 32 + (e & 3) + 8 * (e >> 2) + 4 * hh;
          if (kidx >= tv) s[T][e] = -1e30f;
        }
    }
    float mx = s[0][0];
#pragma unroll
    for (int T = 0; T < 2; ++T)
#pragma unroll
      for (int e = 0; e < 16; ++e) mx = fmaxf(mx, s[T][e]);
    mx = fmaxf(mx, __shfl_xor(mx, 32));
    const float m_new = fmaxf(m_run, mx);
    const float alpha = __builtin_amdgcn_exp2f(m_run - m_new);
    m_run = m_new;
    float rsum = 0.f;
#pragma unroll
    for (int T = 0; T < 2; ++T)
#pragma unroll
      for (int e = 0; e < 16; ++e) { float pv = __builtin_amdgcn_exp2f(s[T][e] - m_new); s[T][e] = pv; rsum += pv; }
    l_run = l_run * alpha + rsum;
#pragma unroll
    for (int i = 0; i < 2; ++i)
#pragma unroll
      for (int e = 0; e < 16; ++e) o[i][e] *= alpha;
#pragma unroll
    for (int T = 0; T < 2; ++T)
#pragma unroll
      for (int ss = 0; ss < 2; ++ss) {
        uint4 pk;
        pk.x = pack2(s[T][8 * ss + 0], s[T][8 * ss + 1]);
        pk.y = pack2(s[T][8 * ss + 2], s[T][8 * ss + 3]);
        pk.z = pack2(s[T][8 * ss + 4], s[T][8 * ss + 5]);
        pk.w = pack2(s[T][8 * ss + 6], s[T][8 * ss + 7]);
        bf16x8 pf = __builtin_bit_cast(bf16x8, pk);
#pragma unroll
        for (int dt = 0; dt < 2; ++dt) {
          const u16* vp = Vb + (dt * 32 + r) * VLD + 32 * T + 16 * ss + 4 * hh;
          uint2 lo = *(const uint2*)vp;
          uint2 hi = *(const uint2*)(vp + 8);
          uint4 vv = make_uint4(lo.x, lo.y, hi.x, hi.y);
          o[dt] = MFMA32(__builtin_bit_cast(bf16x8, vv), pf, o[dt]);
        }
      }
  };
  KVRegs RA, RB;
  prefetch(RA, 0);
  if (1 < nt_all) prefetch(RB, 1);
  lds_write(RA, 0);
  __syncthreads();
  for (int kt = 0; kt < nt_all; kt += 2) {
    if (kt + 2 < nt_all) prefetch(RA, kt + 2);
    if (kt < my_nt) compute(kt);
    if (kt + 1 < nt_all) lds_write(RB, 1);
    __syncthreads();
    if (kt + 1 < nt_all) {
      if (kt + 3 < nt_all) prefetch(RB, kt + 3);
      if (kt + 1 < my_nt) compute(kt + 1);
      if (kt + 2 < nt_all) lds_write(RA, 0);
      __syncthreads();
    }
  }
  if (my_nt > 0) {
    float l = l_run + __shfl_xor(l_run, 32);
    float inv = 1.0f / l;
    int qr = wave * 32 + r;
    if (qr < q_valid) {
#pragma unroll
      for (int dt = 0; dt < 2; ++dt)
#pragma unroll
        for (int g = 0; g < 4; ++g) {
          uint2 st;
          st.x = pack2(o[dt][4 * g + 0] * inv, o[dt][4 * g + 1] * inv);
          st.y = pack2(o[dt][4 * g + 2] * inv, o[dt][4 * g + 3] * inv);
          *(uint2*)(O + (size_t)qr * 512 + dt * 32 + 8 * g + 4 * hh) = st;
        }
    }
  }
  __syncthreads();
}

__device__ __forceinline__ void phase_mixers(const Params& p, char* smem) {
  char* ws = p.ws;
#ifndef SUBM
#define SUBM 3
#endif
  if (SUBM & 1) {
    for (int it = blockIdx.x; it < 2048; it += gridDim.x) scan_item(p, false, it >> 7, (it >> 4) & 7, it & 15, (float*)smem);
    for (int it = blockIdx.x; it < 256; it += gridDim.x) scan_item(p, true, it >> 7, (it >> 4) & 7, it & 15, (float*)smem);
  }
  if (SUBM & 2) {
    int* cnt = (int*)(ws + OFF_CNT);
    int* sitem = (int*)(smem + 81472);
    const u16* Q = (const u16*)(ws + OFF_Q);
    u16* Oat = (u16*)((char*)p.out + SC_OAT);
    constexpr int NITEMS = 128 + 1024 + 16;
    for (;;) {
      if (threadIdx.x == 0) *sitem = atomicAdd(cnt, 1);
      __syncthreads();
      const int it = *sitem;
      __syncthreads();
      if (it >= NITEMS) break;
      size_t q0, k0; int h, ldv, fv, nlo, nhi, qv;
      const u16 *kn, *kr, *vt;
      if (it < 128) {
        int b = it >> 3; h = it & 7;
        q0 = (size_t)TP + b * 16; k0 = (size_t)b * LKS;
        kn = (const u16*)(ws + OFF_R6); kr = (const u16*)(ws + OFF_KRS); vt = (const u16*)(ws + OFF_VTS);
        ldv = LDVS; fv = 64; nlo = LKS; nhi = LKS; qv = 16;
      } else {
        kn = (const u16*)(ws + OFF_KNP); kr = (const u16*)(ws + OFF_KRP); vt = (const u16*)(ws + OFF_VTP);
        ldv = LDVP; fv = 16;
        if (it < 1152) {
          int j = it - 128;
          int qb = 63 - (j >> 4), b = (j >> 3) & 1; h = j & 7;
          k0 = (size_t)b * LP; q0 = k0 + 16 + 128 * qb;
          nlo = 16 + 64 * (2 * qb + 1); nhi = 16 + 64 * (2 * qb + 2); qv = 128;
        } else {
          int j = it - 1152;
          int b = j >> 3; h = j & 7;
          k0 = (size_t)b * LP; q0 = k0;
          nlo = 16; nhi = 16; qv = 16;
        }
      }
      attn_item(Q + q0 * 768 + h * 96, MT - (int)q0, kn + k0 * 512 + h * 64, kr + k0 * 32, vt + (size_t)(h * 64) * ldv + k0, ldv, fv,
                nlo, nhi, Oat + q0 * 512 + h * 64, qv, (u16*)smem);
    }
  }
}

__device__ __forceinline__ void phase_postmix(const Params& p) {
  char* ws = p.ws;
  const int lane = threadIdx.x & 63, wave = threadIdx.x >> 6;
  const u16* Prkv = (const u16*)(ws + OFF_PRKV);
  const u16* Aa = (const u16*)((const char*)p.out + SC_AA);
  const u16* Yb = (const u16*)((const char*)p.out + SC_YB);
  const u16* Oat = (const u16*)((const char*)p.out + SC_OAT);
  const u16* Gg = (const u16*)(ws + OFF_GG);
  u16* Ocat = (u16*)(ws + OFF_OCAT);
  const float* mu_shift = p.in[10];
  const float* k_a = p.in[17]; const float* r_k = p.in[18]; const float* gn_g = p.in[19]; const float* gn_b = p.in[20];
  const float* og = p.in[25];
  for (int m2 = blockIdx.x * 4 + wave; m2 < M2; m2 += gridDim.x * 4) {
    const bool prompt = m2 < 16384;
    const int m = prompt ? ((m2 >> 13) * LP + 16 + (m2 & 8191)) : (TP + m2 - 16384);
    const bool first = (!prompt) && (((m2 - 16384) & 15) == 0);
    const float* ss = p.in[5] + (size_t)(prompt ? 0 : ((m2 - 16384) >> 4)) * CR;
    const u16* row = Prkv + (size_t)m * NRKV;
#pragma unroll 4
    for (int h = 0; h < 8; ++h) {
      int col = h * 64 + lane;
      float y = bf2f(Yb[(size_t)m * 512 + col]);
      float mu = wave_sum(y) * (1.0f / 64.0f);
      float d = y - mu;
      float var = wave_sum(d * d) * (1.0f / 64.0f);
      float yn = d * rsqrtf(var + 64e-5f) * gn_g[col] + gn_b[col];
      const float r = bf2f(row[col]), k = bf2f(row[512 + col]), v = bf2f(row[1024 + col]);
      float a = bf2f(Aa[(size_t)m * 512 + col]);
      float kt = k * (1.0f + (a - 1.0f) * k_a[col]);
      float bs = wave_sum(r * kt * r_k[col]);
      float o = (yn + bs * v) * bf2f(Gg[(size_t)m * 512 + col]);
      Ocat[(size_t)m2 * 1024 + col] = f2bf(o);
    }
    float v[8]; float sq = 0.f;
#pragma unroll
    for (int i = 0; i < 8; ++i) { v[i] = bf2f(Oat[(size_t)m * 512 + lane + 64 * i]); sq += v[i] * v[i]; }
    float rs = rsqrtf(wave_sum(sq) * (1.0f / 512.0f) + 1e-6f);
#pragma unroll
    for (int i = 0; i < 8; ++i) Ocat[(size_t)m2 * 1024 + 512 + lane + 64 * i] = f2bf(v[i] * rs * og[lane + 64 * i]);
  }
}

__device__ __forceinline__ void phase_ln(const Params& p, const float* g, const float* b, u16* hb) {
  const int lane = threadIdx.x & 63, wave = threadIdx.x >> 6;
  const int stride = gridDim.x * 4;
  for (int m2 = blockIdx.x * 4 + wave; m2 < M2; m2 += 2 * stride) {
    const int mB = m2 + stride;
    const bool hasB = mB < M2;
    float* rowA = p.out + (size_t)m2 * 1024;
    float* rowB = p.out + (size_t)(hasB ? mB : m2) * 1024;
    float4 va[4], vb[4];
#pragma unroll
    for (int i = 0; i < 4; ++i) { va[i] = *(const float4*)(rowA + lane * 4 + 256 * i); vb[i] = *(const float4*)(rowB + lane * 4 + 256 * i); }
    float sa = 0.f, sb = 0.f;
#pragma unroll
    for (int i = 0; i < 4; ++i) { sa += va[i].x + va[i].y + va[i].z + va[i].w; sb += vb[i].x + vb[i].y + vb[i].z + vb[i].w; }
    const float muA = wave_sum(sa) * (1.0f / 1024.0f), muB = wave_sum(sb) * (1.0f / 1024.0f);
    float qa = 0.f, qb = 0.f;
#pragma unroll
    for (int i = 0; i < 4; ++i) {
      float a0 = va[i].x - muA, a1 = va[i].y - muA, a2 = va[i].z - muA, a3 = va[i].w - muA;
      float b0 = vb[i].x - muB, b1 = vb[i].y - muB, b2 = vb[i].z - muB, b3 = vb[i].w - muB;
      qa += a0 * a0 + a1 * a1 + a2 * a2 + a3 * a3;
      qb += b0 * b0 + b1 * b1 + b2 * b2 + b3 * b3;
    }
    const float rsA = rsqrtf(wave_sum(qa) * (1.0f / 1024.0f) + 1e-5f), rsB = rsqrtf(wave_sum(qb) * (1.0f / 1024.0f) + 1e-5f);
#pragma unroll
    for (int i = 0; i < 4; ++i) {
      int c = lane * 4 + 256 * i;
      float4 gg = *(const float4*)(g + c), b4 = *(const float4*)(b + c);
      float4 o;
      o.x = (va[i].x - muA) * rsA * gg.x + b4.x; o.y = (va[i].y - muA) * rsA * gg.y + b4.y;
      o.z = (va[i].z - muA) * rsA * gg.z + b4.z; o.w = (va[i].w - muA) * rsA * gg.w + b4.w;
      *(float4*)(rowA + c) = o;
      if (hb) { uint2 t; t.x = pack2(o.x, o.y); t.y = pack2(o.z, o.w); *(uint2*)(hb + (size_t)m2 * 1024 + c) = t; }
      if (hasB) {
        o.x = (vb[i].x - muB) * rsB * gg.x + b4.x; o.y = (vb[i].y - muB) * rsB * gg.y + b4.y;
        o.z = (vb[i].z - muB) * rsB * gg.z + b4.z; o.w = (vb[i].w - muB) * rsB * gg.w + b4.w;
        *(float4*)(rowB + c) = o;
        if (hb) { uint2 t; t.x = pack2(o.x, o.y); t.y = pack2(o.z, o.w); *(uint2*)(hb + (size_t)mB * 1024 + c) = t; }
      }
    }
  }
}

DI void fast_barrier(unsigned* word) {
  asm volatile("s_waitcnt vmcnt(0) lgkmcnt(0)" ::: "memory");
  __syncthreads();
  if (threadIdx.x == 0) {
    __builtin_amdgcn_fence(__ATOMIC_RELEASE, "agent");
    asm volatile("s_waitcnt vmcnt(0)" ::: "memory");
    __hip_atomic_fetch_add(word, 1u, __ATOMIC_RELAXED, __HIP_MEMORY_SCOPE_AGENT);
    const unsigned target = gridDim.x;
    unsigned spins = 0;
    while (__hip_atomic_load(word, __ATOMIC_RELAXED, __HIP_MEMORY_SCOPE_AGENT) < target) {
      __builtin_amdgcn_s_sleep(2);
      if (++spins > (1u << 24)) break;
    }
    __builtin_amdgcn_fence(__ATOMIC_ACQUIRE, "agent");
    asm volatile("s_waitcnt vmcnt(0)" ::: "memory");
  }
  __syncthreads();
}

#define XB_TMO      128
#define XB_XCNT(j)  (256  + 64 * (j))
#define XB_XSUB(j)  (1280 + 64 * (j))
#define XB_XGEN(j)  (2304 + 64 * (j))
#define XB_TOP      3328
#define XB_TOPGEN   3392
#define XB_SPIN_CAP (1u << 20)
DI unsigned xb_ld(unsigned* p) { return __hip_atomic_load(p, __ATOMIC_RELAXED, __HIP_MEMORY_SCOPE_AGENT); }
DI unsigned xb_add(unsigned* p, unsigned v) { return __hip_atomic_fetch_add(p, v, __ATOMIC_RELAXED, __HIP_MEMORY_SCOPE_AGENT); }
DI unsigned xb_xcc_id() { return (unsigned)__builtin_amdgcn_s_getreg((3 << 11) | 20) & 0xFu; }
#define XB_SPIN(cond, bar) do { unsigned _sp = 0; while (cond) { __builtin_amdgcn_s_sleep(1); \
    if ((++_sp & 255u) == 0u) { if (xb_ld(&(bar)[XB_TMO])) break; if (_sp > XB_SPIN_CAP) { atomicAdd(&(bar)[XB_TMO], 1u); break; } } } } while (0)
struct XcdBarrier { unsigned* bar; unsigned x; volatile unsigned* st; };
DI XcdBarrier xcd_barrier_post(unsigned* bar, volatile unsigned* st) {
  XcdBarrier b; b.bar = bar; b.x = xb_xcc_id(); b.st = st;
  if (threadIdx.x == 0) (void)xb_add(&bar[XB_XCNT(b.x)], 1u);
  return b;
}
DI void xcd_barrier_complete(unsigned* bar, unsigned x, unsigned& nloc, unsigned& nx) {
  const unsigned G = gridDim.x;
  unsigned sum, cnt, mine, sp = 0u;
  for (;;) {
    sum = 0u; cnt = 0u; mine = 0u;
#pragma unroll
    for (unsigned j = 0; j < 16; ++j) { const unsigned c = xb_ld(&bar[XB_XCNT(j)]); sum += c; cnt += (c > 0u) ? 1u : 0u; mine = (j == x) ? c : mine; }
    if (sum == G) break;
    __builtin_amdgcn_s_sleep(1);
    if ((++sp & 255u) == 0u) { if (xb_ld(&bar[XB_TMO])) break; if (sp > XB_SPIN_CAP) { atomicAdd(&bar[XB_TMO], 1u); break; } }
  }
  nloc = mine > 0u ? mine : 1u; nx = cnt > 0u ? cnt : 1u;
}
DI void xcd_barrier(const XcdBarrier& b) {
  asm volatile("s_waitcnt vmcnt(0)" ::: "memory");
  __syncthreads();
  if (threadIdx.x == 0) {
    unsigned* bar = b.bar;
    __builtin_amdgcn_s_waitcnt(0);
    unsigned nloc = b.st[0], nx = b.st[1];
    if (nloc == 0u) { xcd_barrier_complete(bar, b.x, nloc, nx); b.st[0] = nloc; b.st[1] = nx; }
    const unsigned old = xb_add(&bar[XB_XSUB(b.x)], 1u);
    const unsigned gen = old / nloc;
    if (old + 1u == (gen + 1u) * nloc) {
      __builtin_amdgcn_fence(__ATOMIC_RELEASE, "agent");
      asm volatile("s_waitcnt vmcnt(0)" ::: "memory");
      const unsigned og = xb_add(&bar[XB_TOP], 1u);
      const unsigned tg = og / nx;
      if (og + 1u == (tg + 1u) * nx) xb_add(&bar[XB_TOPGEN], 1u);
      else XB_SPIN(xb_ld(&bar[XB_TOPGEN]) == tg, bar);
      __builtin_amdgcn_fence(__ATOMIC_ACQUIRE, "agent");
      xb_add(&bar[XB_XGEN(b.x)], 1u);
      asm volatile("s_waitcnt vmcnt(0)" ::: "memory");
    } else {
      XB_SPIN(xb_ld(&bar[XB_XGEN(b.x)]) == gen, bar);
      __builtin_amdgcn_fence(__ATOMIC_ACQUIRE, "agent");
      asm volatile("s_waitcnt vmcnt(0)" ::: "memory");
    }
  }
  __syncthreads();
}

__global__ void __launch_bounds__(256, 2) fwd_megakernel(Params p) {
  __shared__ __attribute__((aligned(16))) char smem[SMEM_BYTES];
  cg::grid_group grid = cg::this_grid();
  char* ws = p.ws;
  unsigned* bar = (unsigned*)(ws + OFF_CNT);

#ifndef PHM
#define PHM 0xFFFF
#endif
  volatile unsigned* xst = (volatile unsigned*)(smem + 81472 + 16);
  if (threadIdx.x == 0) { xst[0] = 0u; xst[1] = 0u; }
  __syncthreads();
  const XcdBarrier xbar = xcd_barrier_post((unsigned*)(ws + OFF_XB), xst);
  if (PHM & 1) phase_prep(p, smem);
  if (p.ws == nullptr) grid.sync();
  xcd_barrier(xbar);
  if (PHM & 2) {
    EpiInproj e{(u16*)(ws + OFF_PRKV), (u16*)(ws + OFF_R6), p.out};
    constexpr int TM = (MT + 127) / 128, TN = (CIN + 127) / 128;
    gemm_phase((const u16*)(ws + OFF_R2), 1024, (const u16*)(ws + OFF_WIN), 1024, MT, CIN, 1024, TM * TN,
               [](int t, int& m0, int& n0) { m0 = (t / TN) * 128; n0 = (t % TN) * 128; }, e, (u16*)smem);
  }
  xcd_barrier(xbar);
  if (PHM & 4) phase_postproj(p);
  {
    ShiftSave sv;
    shift_save(p, sv);
    xcd_barrier(xbar);
    shift_apply(p, sv);
  }
  if (PHM & 8) phase_gemms3(p, (u16*)smem);
  xcd_barrier(xbar);
  if (PHM & 16) phase_mixers(p, smem);
  xcd_barrier(xbar);
  if (PHM & 32) phase_postmix(p);
  xcd_barrier(xbar);
  if (PHM & 64) {
    EpiOut e{p.in[0], p.in[1], (const float*)(ws + OFF_STATS), p.in[7], p.in[8], p.out};
    gemm_phase((const u16*)(ws + OFF_OCAT), 1024, (const u16*)(ws + OFF_WOUT), 1024, M2, 1024, 1024, 130 * 8,
               [](int t, int& m0, int& n0) { m0 = (t >> 3) * 128; n0 = (t & 7) * 128; }, e, (u16*)smem);
  }
  xcd_barrier(xbar);
  if (PHM & 128) phase_ln(p, p.in[27], p.in[28], (u16*)(ws + OFF_H1B));
  xcd_barrier(xbar);
  if (PHM & 256) {
    EpiUp e{(u16*)(ws + OFF_ACT)};
    gemm_phase((const u16*)(ws + OFF_H1B), 1024, (const u16*)(ws + OFF_WUP), 1024, M2, 4096, 1024, 130 * 32,
               [](int t, int& m0, int& n0) { m0 = (t >> 5) * 128; n0 = (t & 31) * 128; }, e, (u16*)smem);
  }
  xcd_barrier(xbar);
  if (PHM & 512) {
    EpiDown e{p.out};
    for (int t = blockIdx.x; t < 130 * 8; t += gridDim.x)
      gemm_tile((const u16*)(ws + OFF_ACT), 4096, (const u16*)(ws + OFF_WDOWN), 4096, M2, 1024, 4096, (t >> 3) * 128, (t & 7) * 128, e,
                (u16*)smem);
  }
  xcd_barrier(xbar);
  if (PHM & 1024) phase_ln(p, p.in[31], p.in[32], nullptr);
}

extern "C" void kernel_launch(void* const* d_in, const int* in_sizes, int n_in, void* d_out, int out_size, void* d_ws,
                              size_t ws_size, hipStream_t stream) {
  static int grid_blocks = 0;
  if (!grid_blocks) {
    int dev = 0, cus = 0, per_cu = 0;
    hipGetDevice(&dev);
    hipDeviceGetAttribute(&cus, hipDeviceAttributeMultiprocessorCount, dev);
    hipOccupancyMaxActiveBlocksPerMultiprocessor(&per_cu, (const void*)fwd_megakernel, 256, 0);
    if (per_cu > 2) per_cu = 2;
    if (per_cu < 1) per_cu = 1;
    grid_blocks = cus * per_cu;
  }
  Params p{};
  for (int i = 0; i < 33; ++i) p.in[i] = (const float*)d_in[i];
  p.out = (float*)d_out;
  p.ws = (char*)d_ws;
  hipMemsetAsync((char*)d_ws + OFF_CNT, 0, 8192, stream);
  hipMemsetAsync((char*)d_ws + OFF_XB, 0, 16384, stream);
  void* args[] = {&p};
  hipError_t e = hipLaunchCooperativeKernel((const void*)fwd_megakernel, dim3(grid_blocks), dim3(256), args, 0, stream);
  if (e != hipSuccess) fprintf(stderr, "cooperative launch failed: %s (grid %d)\n", hipGetErrorString(e), grid_blocks);
}
```

```cpp
#include <hip/hip_runtime.h>
#include <hip/hip_cooperative_groups.h>
#include <cstdio>
namespace cg = cooperative_groups;

typedef unsigned short u16;
typedef __attribute__((ext_vector_type(8))) short bf16x8;
typedef __attribute__((ext_vector_type(16))) float f32x16;
typedef __attribute__((ext_vector_type(2))) float f32x2;
typedef __attribute__((ext_vector_type(4))) unsigned u32x4;
typedef __attribute__((ext_vector_type(2))) unsigned u32x2;
typedef __attribute__((ext_vector_type(2))) __bf16 bf16x2_t;

#define DI __device__ __forceinline__
#define MFMA32(a, b, c) __builtin_amdgcn_mfma_f32_32x32x16_bf16((a), (b), (c), 0, 0, 0)

constexpr int D_ = 1024;
constexpr int LP = 8208;
constexpr int TP = 16416;
constexpr int TS = 256;
constexpr int MT = TP + TS;
constexpr int M2 = 16640;
constexpr int LKS = 2064;
constexpr int TKS = 16 * LKS;
constexpr int CR = 1792;
constexpr int CIN = 2464;
constexpr int NRKV = 1536;
constexpr int NREST = 928;
constexpr int LDVP = TP + 64;
constexpr int LDVS = TKS + 64;

constexpr size_t OFF_WIN = 0;
constexpr size_t OFF_WQB = OFF_WIN + (size_t)CIN * 1024 * 2;
constexpr size_t OFF_WKN = OFF_WQB + (size_t)768 * 384 * 2;
constexpr size_t OFF_WV = OFF_WKN + (size_t)512 * 256 * 2;
constexpr size_t OFF_WDEC = OFF_WV + (size_t)512 * 256 * 2;
constexpr size_t OFF_WAAA = OFF_WDEC + (size_t)512 * 64 * 2;
constexpr size_t OFF_WGATE = OFF_WAAA + (size_t)512 * 64 * 2;
constexpr size_t OFF_WOUT = OFF_WGATE + (size_t)512 * 128 * 2;
constexpr size_t OFF_WUP = OFF_WOUT + (size_t)1024 * 1024 * 2;
constexpr size_t OFF_WDOWN = OFF_WUP + (size_t)4096 * 1024 * 2;
constexpr size_t OFF_PRKV = OFF_WDOWN + (size_t)4096 * 1024 * 2;
constexpr size_t OFF_R2 = OFF_PRKV + (size_t)MT * NRKV * 2;
constexpr size_t OFF_GG = OFF_R2 + (size_t)MT * 1024 * 2;
constexpr size_t OFF_Q = OFF_GG + (size_t)MT * 512 * 2;
constexpr size_t OFF_KNP = OFF_Q + (size_t)MT * 768 * 2;
constexpr size_t OFF_VTP = OFF_KNP + (size_t)(TP + 64) * 512 * 2;
constexpr size_t OFF_R6 = OFF_VTP + (size_t)512 * LDVP * 2;
constexpr size_t OFF_VTS = OFF_R6 + (size_t)(TKS + 64) * 512 * 2;
constexpr size_t OFF_KRP = OFF_VTS + (size_t)512 * LDVS * 2;
constexpr size_t OFF_KRS = OFF_KRP + (size_t)(TP + 64) * 32 * 2;
constexpr size_t OFF_ROPE = OFF_KRS + (size_t)(TKS + 64) * 32 * 2;
constexpr size_t OFF_STATS = OFF_ROPE + (size_t)LP * 16 * 4 * 2;
constexpr size_t OFF_CNT = OFF_STATS + (size_t)MT * 2 * 4;
constexpr size_t OFF_PRE8 = OFF_CNT + 8192;
constexpr size_t OFF_XB = OFF_PRE8 + (size_t)MT * 8 * 4;
constexpr size_t WS_END = OFF_XB + 16384;
static_assert(WS_END < (size_t)256 * 1024 * 1024, "ws overflow");
constexpr size_t OFF_OCAT = OFF_R6;
constexpr size_t OFF_H1B = OFF_PRKV;
constexpr size_t OFF_ACT = OFF_R2;
static_assert(OFF_ACT + (size_t)M2 * 4096 * 2 < (size_t)256 * 1024 * 1024, "act overflow");
static_assert((size_t)M2 * 1024 * 2 <= (size_t)MT * NRKV * 2, "h1b overflow");

constexpr size_t SC_AA = 0;
constexpr size_t SC_LIN = SC_AA + (size_t)MT * 512 * 2;
constexpr size_t SC_QN = SC_LIN + (size_t)MT * 256 * 2;
constexpr size_t SC_CBP = SC_QN + (size_t)MT * 384 * 2;
constexpr size_t SC_CBS = SC_CBP + (size_t)TP * 256 * 2;
constexpr size_t SC_END = SC_CBS + (size_t)TKS * 256 * 2;
static_assert(SC_END <= (size_t)2 * 8192 * 1024 * 4, "scratch overflow");
constexpr size_t SC_YB = SC_LIN;
constexpr size_t SC_OAT = SC_CBP;
static_assert(SC_YB + (size_t)MT * 512 * 2 <= SC_CBP, "yb overflow");
static_assert(SC_OAT + (size_t)MT * 512 * 2 <= SC_END, "oat overflow");

constexpr size_t O_Y = 0;
constexpr size_t O_LATP = (size_t)M2 * 1024;
constexpr size_t O_ROPEP = O_LATP + (size_t)TP * 256;
constexpr size_t O_STATEP = O_ROPEP + (size_t)TP * 32;
constexpr size_t O_SHIFTP = O_STATEP + (size_t)2 * 8 * 64 * 64;
constexpr size_t O_LATS = O_SHIFTP + (size_t)2 * CR;
constexpr size_t O_ROPES = O_LATS + (size_t)TS * 256;
constexpr size_t O_STATES = O_ROPES + (size_t)TS * 32;
constexpr size_t O_SHIFTS = O_STATES + (size_t)16 * 8 * 64 * 64;

constexpr float ALPHA = 1.189207115002721f;
constexpr float DECAY_SCALE = 0.6065306597126334f;
constexpr float QSCALE = 0.10206207261596577f * 1.4426950408889634f;

constexpr int SMEM_BYTES = 81472 + 64;

struct Params {
  const float* in[33];
  float* out;
  char* ws;
};

DI u16 f2bf(float f) { unsigned u = __float_as_uint(f); u += 0x7FFFu + ((u >> 16) & 1u); return (u16)(u >> 16); }
DI float bf2f(u16 h) { return __uint_as_float(((unsigned)h) << 16); }
DI unsigned pack2(float a, float b) {
  f32x2 v = {a, b};
  bf16x2_t r = __builtin_convertvector(v, bf16x2_t);
  return __builtin_bit_cast(unsigned, r);
}
template <int CTRL> DI float dppf(float x) {
  return __int_as_float(__builtin_amdgcn_mov_dpp(__float_as_int(x), CTRL, 0xF, 0xF, true));
}
DI float allreduce16(float x) {
  x += dppf<0xB1>(x);
  x += dppf<0x4E>(x);
  x += dppf<0x141>(x);
  x += dppf<0x140>(x);
  return x;
}
DI float allreduce32(float x) {
  x = allreduce16(x);
  auto t = __builtin_amdgcn_permlane16_swap(__float_as_uint(x), __float_as_uint(x), false, false);
  return __uint_as_float(t[0]) + __uint_as_float(t[1]);
}
DI float wave_sum(float x) {
  x = allreduce32(x);
  auto t = __builtin_amdgcn_permlane32_swap(__float_as_uint(x), __float_as_uint(x), false, false);
  return __uint_as_float(t[0]) + __uint_as_float(t[1]);
}
DI float sigmoidf_(float x) { return 1.0f / (1.0f + __expf(-x)); }
DI float tanhf_(float x) { float e = __expf(2.0f * x); return 1.0f - 2.0f / (e + 1.0f); }

constexpr int GLD = 72;
constexpr int GBUF = 256 * GLD;
template <class Epi>
__device__ __forceinline__ void gemm_tile(const u16* __restrict__ A, int lda, const u16* __restrict__ Bt, int ldb,
                          int M, int N, int K, int m0, int n0, Epi& epi, u16* smem, int kbeg = 0) {
  u16* As = smem;
  u16* Bs = smem + 128 * GLD;
  const int tid = threadIdx.x, lane = tid & 63, wave = tid >> 6;
  const int wm = wave >> 1, wn = wave & 1;
  const int r = lane & 31, hh = lane >> 5;
  size_t aoff[4], boff[4];
  int soff[4];
#pragma unroll
  for (int i = 0; i < 4; ++i) {
    int c = tid + 256 * i;
    int row = c >> 3, kc = c & 7;
    int ar = m0 + row; ar = ar < M ? ar : M - 1;
    int br = n0 + row; br = br < N ? br : N - 1;
    aoff[i] = (size_t)ar * lda + kc * 8 + kbeg;
    boff[i] = (size_t)br * ldb + kc * 8 + kbeg;
    soff[i] = row * GLD + kc * 8;
  }
  struct GRegs { u32x4 a[4], b[4]; };
  auto prefetch = [&](GRegs& R, int kt) {
#pragma unroll
    for (int i = 0; i < 4; ++i) {
      R.a[i] = *(const u32x4*)(A + aoff[i] + (size_t)kt * 64);
      R.b[i] = *(const u32x4*)(Bt + boff[i] + (size_t)kt * 64);
    }
  };
  auto lds_write = [&](const GRegs& R, int buf) {
#pragma unroll
    for (int i = 0; i < 4; ++i) {
      *(u32x4*)(As + buf * GBUF + soff[i]) = R.a[i];
      *(u32x4*)(Bs + buf * GBUF + soff[i]) = R.b[i];
    }
  };
  f32x16 acc[2][2];
#pragma unroll
  for (int i = 0; i < 2; ++i)
#pragma unroll
    for (int j = 0; j < 2; ++j)
#pragma unroll
      for (int e = 0; e < 16; ++e) acc[i][j][e] = 0.f;
  auto compute = [&](int buf) {
    const u16* Ab = As + buf * GBUF;
    const u16* Bb = Bs + buf * GBUF;
#pragma unroll
    for (int ks = 0; ks < 4; ++ks) {
      bf16x8 af[2], bfr[2];
#pragma unroll
      for (int i = 0; i < 2; ++i) {
        af[i] = *(const bf16x8*)(Ab + (wm * 64 + i * 32 + r) * GLD + ks * 16 + hh * 8);
        bfr[i] = *(const bf16x8*)(Bb + (wn * 64 + i * 32 + r) * GLD + ks * 16 + hh * 8);
      }
#pragma unroll
      for (int i = 0; i < 2; ++i)
#pragma unroll
        for (int j = 0; j < 2; ++j) acc[i][j] = MFMA32(af[i], bfr[j], acc[i][j]);
    }
  };
  const int nk = K >> 6;
  GRegs RA, RB;
  prefetch(RA, 0);
  if (1 < nk) prefetch(RB, 1);
  lds_write(RA, 0);
  __syncthreads();
  for (int kt = 0; kt < nk; kt += 2) {
    if (kt + 2 < nk) prefetch(RA, kt + 2);
    compute(0);
    if (kt + 1 < nk) lds_write(RB, 1);
    __syncthreads();
    if (kt + 1 < nk) {
      if (kt + 3 < nk) prefetch(RB, kt + 3);
      compute(1);
      if (kt + 2 < nk) lds_write(RA, 0);
      __syncthreads();
    }
  }
#pragma unroll
  for (int i = 0; i < 2; ++i)
#pragma unroll
    for (int j = 0; j < 2; ++j) {
      const int col = n0 + wn * 64 + j * 32 + r;
#pragma unroll
      for (int e = 0; e < 16; ++e) {
        const int row = m0 + wm * 64 + i * 32 + (e & 3) + 8 * (e >> 2) + 4 * hh;
        epi(row, col, acc[i][j][e], (row < M) && (col < N));
      }
    }
}

template <class Epi, class Map>
__device__ __forceinline__ void gemm_phase(const u16* __restrict__ A, int lda, const u16* __restrict__ Bt, int ldb,
                                           int M, int N, int K, int ntiles, Map tmap, Epi& epi, u16* smem) {
  u16* As = smem;
  u16* Bs = smem + 128 * GLD;
  const int tid = threadIdx.x, lane = tid & 63, wave = tid >> 6;
  const int wm = wave >> 1, wn = wave & 1;
  const int r = lane & 31, hh = lane >> 5;
  int t = blockIdx.x;
  if (t >= ntiles) return;
  size_t aoff[4], boff[4];
  int soff[4];
#pragma unroll
  for (int i = 0; i < 4; ++i) { int c = tid + 256 * i; soff[i] = (c >> 3) * GLD + (c & 7) * 8; }
  auto set_tile = [&](int m0, int n0) {
#pragma unroll
    for (int i = 0; i < 4; ++i) {
      int c = tid + 256 * i;
      int row = c >> 3, kc = c & 7;
      int ar = m0 + row; ar = ar < M ? ar : M - 1;
      int br = n0 + row; br = br < N ? br : N - 1;
      aoff[i] = (size_t)ar * lda + kc * 8;
      boff[i] = (size_t)br * ldb + kc * 8;
    }
  };
  struct GRegs { u32x4 a[4], b[4]; };
  auto prefetch = [&](GRegs& R, int kt) {
#pragma unroll
    for (int i = 0; i < 4; ++i) {
      R.a[i] = *(const u32x4*)(A + aoff[i] + (size_t)kt * 64);
      R.b[i] = *(const u32x4*)(Bt + boff[i] + (size_t)kt * 64);
    }
  };
  auto lds_write = [&](const GRegs& R, int buf) {
#pragma unroll
    for (int i = 0; i < 4; ++i) {
      *(u32x4*)(As + buf * GBUF + soff[i]) = R.a[i];
      *(u32x4*)(Bs + buf * GBUF + soff[i]) = R.b[i];
    }
  };
  const int nk = K >> 6;
  GRegs RA, RB;
  int m0, n0;
  tmap(t, m0, n0);
  set_tile(m0, n0);
  prefetch(RA, 0);
  prefetch(RB, 1);
  for (;;) {
    f32x16 acc[2][2];
#pragma unroll
    for (int i = 0; i < 2; ++i)
#pragma unroll
      for (int j = 0; j < 2; ++j)
#pragma unroll
        for (int e = 0; e < 16; ++e) acc[i][j][e] = 0.f;
    auto compute = [&](int buf) {
      const u16* Ab = As + buf * GBUF;
      const u16* Bb = Bs + buf * GBUF;
#pragma unroll
      for (int ks = 0; ks < 4; ++ks) {
        bf16x8 af[2], bfr[2];
#pragma unroll
        for (int i = 0; i < 2; ++i) {
          af[i] = *(const bf16x8*)(Ab + (wm * 64 + i * 32 + r) * GLD + ks * 16 + hh * 8);
          bfr[i] = *(const bf16x8*)(Bb + (wn * 64 + i * 32 + r) * GLD + ks * 16 + hh * 8);
        }
#pragma unroll
        for (int i = 0; i < 2; ++i)
#pragma unroll
          for (int j = 0; j < 2; ++j) acc[i][j] = MFMA32(af[i], bfr[j], acc[i][j]);
      }
    };
    lds_write(RA, 0);
    __syncthreads();
    for (int kt = 0; kt < nk; kt += 2) {
      if (kt + 2 < nk) prefetch(RA, kt + 2);
      compute(0);
      lds_write(RB, 1);
      __syncthreads();
      if (kt + 3 < nk) prefetch(RB, kt + 3);
      compute(1);
      if (kt + 2 < nk) lds_write(RA, 0);
      __syncthreads();
    }
    const int tn = t + (int)gridDim.x;
    const bool more = tn < ntiles;
    const int cm0 = m0, cn0 = n0;
    if (more) {
      tmap(tn, m0, n0);
      set_tile(m0, n0);
      prefetch(RA, 0);
    }
#pragma unroll
    for (int i = 0; i < 2; ++i)
#pragma unroll
      for (int j = 0; j < 2; ++j) {
        const int col = cn0 + wn * 64 + j * 32 + r;
#pragma unroll
        for (int e = 0; e < 16; ++e) {
          const int row = cm0 + wm * 64 + i * 32 + (e & 3) + 8 * (e >> 2) + 4 * hh;
          epi(row, col, acc[i][j][e], (row < M) && (col < N));
        }
      }
    if (!more) break;
    prefetch(RB, 1);
    t = tn;
  }
}

struct EpiInproj {
  u16* prkv; u16* prest; float* out;
  DI void operator()(int row, int col, float v, bool valid) const {
    if (!valid) return;
    if (col < NRKV) prkv[(size_t)row * NRKV + col] = f2bf(v);
    else prest[(size_t)row * NREST + (col - NRKV)] = f2bf(v);
    if (col < CR) {
      if (row < TP) {
        if (row == LP - 1) out[O_SHIFTP + col] = v;
        else if (row == 2 * LP - 1) out[O_SHIFTP + CR + col] = v;
      } else {
        int s = row - TP;
        if ((s & 15) == 15) out[O_SHIFTS + (size_t)(s >> 4) * CR + col] = v;
      }
    }
  }
};
struct EpiDecay {
  float* wd; const float* base;
  DI void operator()(int row, int col, float v, bool valid) const {
    if (valid) wd[(size_t)row * 512 + col] = __expf(-DECAY_SCALE * sigmoidf_(base[col] + v));
  }
};
struct EpiAaa {
  u16* aa; const float* base;
  DI void operator()(int row, int col, float v, bool valid) const {
    if (valid) aa[(size_t)row * 512 + col] = f2bf(sigmoidf_(base[col] + v));
  }
};
struct EpiStoreBf {
  u16* dst; int ld;
  DI void operator()(int row, int col, float v, bool valid) const {
    if (valid) dst[(size_t)row * ld + col] = f2bf(v);
  }
};
struct EpiQ {
  u16* q; const float* cosT; const float* sinT;
  DI void operator()(int row, int col, float v, bool valid) const {
    int dcol = col % 96;
    float partner = __shfl_xor(v, 16);
    if (dcol >= 64) {
      int rr = row < MT ? row : MT - 1;
      int pos = rr < TP ? (rr % LP) : 2048 + ((rr - TP) & 15);
      int i = (dcol - 64) & 15;
      float c = cosT[pos * 16 + i], s = sinT[pos * 16 + i];
      v = (dcol < 80) ? (v * c - partner * s) : (partner * s + v * c);
    }
    if (valid) q[(size_t)row * 768 + col] = f2bf(v * QSCALE);
  }
};
struct EpiOut {
  const float* x; const float* xs; const float* stats; const float* g; const float* b; float* out;
  DI void operator()(int row, int col, float v, bool valid) const {
    if (!valid) return;
    int m = row < 16384 ? ((row >> 13) * LP + 16 + (row & 8191)) : (TP + row - 16384);
    float mu = stats[2 * m], rs = stats[2 * m + 1];
    const float xv = row < 16384 ? x[(size_t)row * 1024 + col] : xs[(size_t)(row - 16384) * 1024 + col];
    float h = (xv - mu) * rs * g[col] + b[col];
    out[(size_t)row * 1024 + col] = ALPHA * h + v;
  }
};
struct EpiUp {
  u16* act;
  DI void operator()(int row, int col, float v, bool valid) const {
    if (valid) { float t = v > 0.f ? v : 0.f; act[(size_t)row * 4096 + col] = f2bf(t * t); }
  }
};
struct EpiDown {
  float* out;
  DI void operator()(int row, int col, float v, bool valid) const {
    if (valid) { size_t o = (size_t)row * 1024 + col; out[o] = out[o] + v; }
  }
};
struct EpiDownAtomic {
  float* out;
  DI void operator()(int row, int col, float v, bool valid) const {
    if (valid) atomicAdd(out + (size_t)row * 1024 + col, v);
  }
};

__device__ __forceinline__ void transpose_tiles(const float* __restrict__ src, int ld_src, u16* __restrict__ dst, int K, int Nd, int mode,
                                float* tl) {
  const int tid = threadIdx.x, tx = tid & 31, ty = tid >> 5;
  const int ntn = Nd >> 5, ntk = K >> 5;
  for (int t = blockIdx.x; t < ntn * ntk; t += gridDim.x) {
    int tn = t % ntn, tk = t / ntn;
    int n0 = tn * 32, k0 = tk * 32;
    int n = n0 + tx;
    int sc = mode == 0 ? n : ((n >> 6) * 128 + (n & 63) + (mode == 2 ? 64 : 0));
#pragma unroll
    for (int i = 0; i < 4; ++i) {
      int k = k0 + ty + 8 * i;
      tl[(ty + 8 * i) * 33 + tx] = src[(size_t)k * ld_src + sc];
    }
    __syncthreads();
#pragma unroll
    for (int i = 0; i < 4; ++i) {
      int nn = ty + 8 * i;
      dst[(size_t)(n0 + nn) * K + k0 + tx] = f2bf(tl[tx * 33 + nn]);
    }
    __syncthreads();
  }
}

__device__ __forceinline__ void phase_prep(const Params& p, char* smem) {
  char* ws = p.ws;
  float* tl = (float*)smem;
  transpose_tiles(p.in[9], CIN, (u16*)(ws + OFF_WIN), 1024, CIN, 0, tl);
  transpose_tiles(p.in[22], 768, (u16*)(ws + OFF_WQB), 384, 768, 0, tl);
  transpose_tiles(p.in[24], 1024, (u16*)(ws + OFF_WKN), 256, 512, 1, tl);
  transpose_tiles(p.in[24], 1024, (u16*)(ws + OFF_WV), 256, 512, 2, tl);
  transpose_tiles(p.in[11], 512, (u16*)(ws + OFF_WDEC), 64, 512, 0, tl);
  transpose_tiles(p.in[13], 512, (u16*)(ws + OFF_WAAA), 64, 512, 0, tl);
  transpose_tiles(p.in[15], 512, (u16*)(ws + OFF_WGATE), 128, 512, 0, tl);
  transpose_tiles(p.in[26], 1024, (u16*)(ws + OFF_WOUT), 1024, 1024, 0, tl);
  transpose_tiles(p.in[29], 4096, (u16*)(ws + OFF_WUP), 1024, 4096, 0, tl);
  transpose_tiles(p.in[30], 1024, (u16*)(ws + OFF_WDOWN), 4096, 1024, 0, tl);

  const int tid = threadIdx.x, lane = tid & 63, wave = tid >> 6;
  {
    u16* Hb = (u16*)(ws + OFF_R2);
    float* stats = (float*)(ws + OFF_STATS);
    const float* g = p.in[7]; const float* bb = p.in[8];
    auto rowsrc = [&](int m) -> const float* {
      if (m < TP) { int b = m / LP, l = m % LP; return l < 16 ? p.in[6] + (size_t)l * 1024 : p.in[0] + ((size_t)b * 8192 + (l - 16)) * 1024; }
      return p.in[1] + (size_t)(m - TP) * 1024;
    };
    const int stride = gridDim.x * 4;
    int m = blockIdx.x * 4 + wave;
    float4 v[4], vn[4];
    if (m < MT) {
      const float* src = rowsrc(m);
#pragma unroll
      for (int i = 0; i < 4; ++i) v[i] = *(const float4*)(src + lane * 4 + 256 * i);
    }
    for (; m < MT; m += stride) {
      const int mn = m + stride;
      {
        const float* srcn = rowsrc(mn < MT ? mn : m);
#pragma unroll
        for (int i = 0; i < 4; ++i) vn[i] = *(const float4*)(srcn + lane * 4 + 256 * i);
      }
      float s = 0.f;
#pragma unroll
      for (int i = 0; i < 4; ++i) s += v[i].x + v[i].y + v[i].z + v[i].w;
      float mu = wave_sum(s) * (1.0f / 1024.0f);
      float q = 0.f;
#pragma unroll
      for (int i = 0; i < 4; ++i) { float a = v[i].x - mu, b2 = v[i].y - mu, c = v[i].z - mu, d = v[i].w - mu; q += a * a + b2 * b2 + c * c + d * d; }
      float rs = rsqrtf(wave_sum(q) * (1.0f / 1024.0f) + 1e-5f);
      if (lane == 0) { stats[2 * m] = mu; stats[2 * m + 1] = rs; }
#pragma unroll
      for (int i = 0; i < 4; ++i) {
        int c = lane * 4 + 256 * i;
        float4 gg = *(const float4*)(g + c), b4 = *(const float4*)(bb + c);
        uint2 o;
        o.x = pack2((v[i].x - mu) * rs * gg.x + b4.x, (v[i].y - mu) * rs * gg.y + b4.y);
        o.y = pack2((v[i].z - mu) * rs * gg.z + b4.z, (v[i].w - mu) * rs * gg.w + b4.w);
        *(uint2*)(Hb + (size_t)m * 1024 + c) = o;
      }
#pragma unroll
      for (int i = 0; i < 4; ++i) v[i] = vn[i];
    }
  }
  const size_t gtid = (size_t)blockIdx.x * 256 + tid, gsz = (size_t)gridDim.x * 256;
  {
    float* cosT = (float*)(ws + OFF_ROPE); float* sinT = cosT + LP * 16;
    for (size_t e = gtid; e < (size_t)LP * 16; e += gsz) {
      int pos = (int)(e >> 4), i = (int)(e & 15);
      double inv = exp(-(double)(2 * i) / 32.0 * 9.210340371976184);
      double rev = (double)pos * inv * 0.15915494309189535;
      rev -= rint(rev);
      float rf = (float)rev;
      cosT[e] = __builtin_amdgcn_cosf(rf);
      sinT[e] = __builtin_amdgcn_sinf(rf);
    }
  }
  {
    u16* CbS = (u16*)((char*)p.out + SC_CBS);
    const float* cl = p.in[2];
    for (size_t e0 = gtid; e0 < (size_t)16 * 2048 * 64; e0 += 4 * gsz) {
      float4 v[4]; size_t ee[4];
#pragma unroll
      for (int u = 0; u < 4; ++u) {
        ee[u] = e0 + u * gsz; if (ee[u] >= (size_t)16 * 2048 * 64) ee[u] = e0;
        v[u] = *(const float4*)(cl + (ee[u] >> 6) * 256 + (ee[u] & 63) * 4);
      }
#pragma unroll
      for (int u = 0; u < 4; ++u) {
        size_t row = ee[u] >> 6; int c4 = (int)(ee[u] & 63);
        int b = (int)(row >> 11), key = (int)(row & 2047);
        uint2 o; o.x = pack2(v[u].x, v[u].y); o.y = pack2(v[u].z, v[u].w);
        *(uint2*)(CbS + ((size_t)b * LKS + key) * 256 + c4 * 4) = o;
      }
    }
    u16* KRs = (u16*)(ws + OFF_KRS);
    const float* cr = p.in[3];
    for (size_t e = gtid; e < (size_t)16 * 2048 * 8; e += gsz) {
      size_t row = e >> 3; int c4 = (int)(e & 7);
      int b = (int)(row >> 11), key = (int)(row & 2047);
      float4 v = *(const float4*)(cr + row * 32 + c4 * 4);
      uint2 o; o.x = pack2(v.x, v.y); o.y = pack2(v.z, v.w);
      *(uint2*)(KRs + ((size_t)b * LKS + key) * 32 + c4 * 4) = o;
    }
  }
}

__device__ __forceinline__ void phase_postproj(const Params& p) {
  char* ws = p.ws;
  const int lane = threadIdx.x & 63, wave = threadIdx.x >> 6;
  const u16* Prest = (const u16*)(ws + OFF_R6);
  u16* Lin = (u16*)((char*)p.out + SC_LIN);
  u16* Qn = (u16*)((char*)p.out + SC_QN);
  u16* CbP = (u16*)((char*)p.out + SC_CBP);
  u16* CbS = (u16*)((char*)p.out + SC_CBS);
  u16* KRp = (u16*)(ws + OFF_KRP);
  u16* KRs = (u16*)(ws + OFF_KRS);
  const float* cosT = (const float*)(ws + OFF_ROPE); const float* sinT = cosT + LP * 16;
  const float* mu_shift = p.in[10];
  const float* sshift = p.in[5];
  const float* qg = p.in[21]; const float* kvg = p.in[23];
  for (int m = blockIdx.x * 4 + wave; m < MT; m += gridDim.x * 4) {
    const bool prompt = m < TP;
    int b, l;
    if (prompt) { b = m / LP; l = m % LP; } else { b = (m - TP) >> 4; l = (m - TP) & 15; }
    const u16* row = Prest + (size_t)m * NREST;
#pragma unroll
    for (int i = 0; i < 4; ++i) {
      int c = lane + 64 * i;
      float cur = bf2f(row[c]);
      float prev;
      if (l > 0) prev = bf2f(row[c - NREST]);
      else prev = prompt ? 0.f : sshift[(size_t)b * CR + NRKV + c];
      float x = cur + mu_shift[NRKV + c] * (prev - cur);
      float o = i == 0 ? tanhf_(x) : (i == 1 ? x : sigmoidf_(x));
      Lin[(size_t)m * 256 + c] = f2bf(o);
    }
    {
      float v[6]; float ss = 0.f;
#pragma unroll
      for (int i = 0; i < 6; ++i) { v[i] = bf2f(row[256 + lane + 64 * i]); ss += v[i] * v[i]; }
      float rs = rsqrtf(wave_sum(ss) * (1.0f / 384.0f) + 1e-6f);
#pragma unroll
      for (int i = 0; i < 6; ++i) Qn[(size_t)m * 384 + lane + 64 * i] = f2bf(v[i] * rs * qg[lane + 64 * i]);
    }
    {
      float v[4]; float ss = 0.f;
#pragma unroll
      for (int i = 0; i < 4; ++i) { v[i] = bf2f(row[640 + lane + 64 * i]); ss += v[i] * v[i]; }
      float rs = rsqrtf(wave_sum(ss) * (1.0f / 256.0f) + 1e-6f);
      float* lo = prompt ? p.out + O_LATP + (size_t)m * 256 : p.out + O_LATS + (size_t)(m - TP) * 256;
      u16* cb = prompt ? CbP + (size_t)m * 256 : CbS + ((size_t)b * LKS + 2048 + l) * 256;
#pragma unroll
      for (int i = 0; i < 4; ++i) {
        float c = v[i] * rs * kvg[lane + 64 * i];
        lo[lane + 64 * i] = c;
        cb[lane + 64 * i] = f2bf(c);
      }
    }
    {
      int i = lane & 15;
      float x1 = bf2f(row[896 + i]), x2 = bf2f(row[912 + i]);
      int pos = prompt ? l : 2048 + l;
      float c = cosT[pos * 16 + i], s = sinT[pos * 16 + i];
      float o1 = x1 * c - x2 * s, o2 = x1 * s + x2 * c;
      float* ro = prompt ? p.out + O_ROPEP + (size_t)m * 32 : p.out + O_ROPES + (size_t)(m - TP) * 32;
      u16* kr = prompt ? KRp + (size_t)m * 32 : KRs + ((size_t)b * LKS + 2048 + l) * 32;
      if (lane < 16) { ro[i] = o1; ro[16 + i] = o2; kr[i] = f2bf(o1); kr[16 + i] = f2bf(o2); }
    }
  }
}

struct ShiftSave { unsigned d[12]; };
__device__ __forceinline__ void shift_save(const Params& p, ShiftSave& sv) {
  const int lane = threadIdx.x & 63, wave = threadIdx.x >> 6;
  const int tpw = (MT + (int)gridDim.x * 4 - 1) / ((int)gridDim.x * 4);
  const int m_lo = (blockIdx.x * 4 + wave) * tpw;
  const unsigned* Pd = (const unsigned*)(p.ws + OFF_PRKV);
  const int mr = (m_lo > 0 && m_lo < MT) ? m_lo - 1 : 0;
#pragma unroll
  for (int i = 0; i < 12; ++i) sv.d[i] = Pd[(size_t)mr * (NRKV / 2) + lane + 64 * i];
}
__device__ __forceinline__ void shift_apply(const Params& p, const ShiftSave& sv) {
  const int lane = threadIdx.x & 63, wave = threadIdx.x >> 6;
  const int tpw = (MT + (int)gridDim.x * 4 - 1) / ((int)gridDim.x * 4);
  const int m_lo = (blockIdx.x * 4 + wave) * tpw;
  if (m_lo >= MT) return;
  const int m_hi = (m_lo + tpw < MT) ? m_lo + tpw : MT;
  unsigned* Pd = (unsigned*)(p.ws + OFF_PRKV);
  float* PRE8 = (float*)(p.ws + OFF_PRE8);
  const float* mu = p.in[10];
  const float* k_k = p.in[16];
  for (int m = m_hi - 1; m >= m_lo; --m) {
    const bool prompt = m < TP;
    int b, l;
    if (prompt) { b = m / LP; l = m % LP; } else { b = (m - TP) >> 4; l = (m - TP) & 15; }
    unsigned* row = Pd + (size_t)m * (NRKV / 2);
    unsigned cur[12], prv[12];
#pragma unroll
    for (int i = 0; i < 12; ++i) cur[i] = row[lane + 64 * i];
    if (l > 0 && m > m_lo) {
#pragma unroll
      for (int i = 0; i < 12; ++i) prv[i] = row[lane + 64 * i - NRKV / 2];
    } else {
#pragma unroll
      for (int i = 0; i < 12; ++i) prv[i] = sv.d[i];
    }
#pragma unroll
    for (int i = 0; i < 12; ++i) {
      const int c = 2 * (lane + 64 * i);
      float c0 = __uint_as_float(cur[i] << 16), c1 = __uint_as_float(cur[i] & 0xFFFF0000u);
      float p0 = __uint_as_float(prv[i] << 16), p1 = __uint_as_float(prv[i] & 0xFFFF0000u);
      if (l == 0) {
        if (prompt) { p0 = 0.f; p1 = 0.f; }
        else { const float2 q = *(const float2*)(p.in[5] + (size_t)b * CR + c); p0 = q.x; p1 = q.y; }
      }
      const float2 mm = *(const float2*)(mu + c);
      const float o0 = c0 + mm.x * (p0 - c0), o1 = c1 + mm.y * (p1 - c1);
      row[lane + 64 * i] = pack2(o0, o1);
      if (i >= 4 && i < 8) {
        const float2 kw = *(const float2*)(k_k + c - 512);
        const float q0 = o0 * kw.x, q1 = o1 * kw.y;
        const float ss = allreduce32(fmaf(q0, q0, q1 * q1));
        if ((lane & 31) == 0) PRE8[(size_t)m * 8 + 2 * (i - 4) + (lane >> 5)] = __builtin_amdgcn_rsqf(fmaxf(ss, 1e-24f));
      }
    }
  }
}

__device__ __forceinline__ void phase_gemms3(const Params& p, u16* smem) {
  char* ws = p.ws;
  const u16* Lin = (const u16*)((char*)p.out + SC_LIN);
  const u16* Qn = (const u16*)((char*)p.out + SC_QN);
  const u16* CbP = (const u16*)((char*)p.out + SC_CBP);
  const u16* CbS = (const u16*)((char*)p.out + SC_CBS);
  constexpr int TM = (MT + 127) / 128;
  constexpr int TMP = (TP + 127) / 128;
  constexpr int TMS = TKS / 128;
  constexpr int J0 = TM * 4, J1 = J0 + TM * 4, J2 = J1 + TM * 4, J3 = J2 + TM * 6, J4 = J3 + TMP * 4, J5 = J4 + TMP * 4,
                J6 = J5 + TMS * 4, J7 = J6 + TMS * 4;
  for (int t = blockIdx.x; t < J7; t += gridDim.x) {
    if (t < J0) {
      EpiDecay e{(float*)(ws + OFF_R2), p.in[12]};
      gemm_tile(Lin, 256, (const u16*)(ws + OFF_WDEC), 64, MT, 512, 64, (t >> 2) * 128, (t & 3) * 128, e, smem);
    } else if (t < J1) {
      int u = t - J0;
      EpiAaa e{(u16*)((char*)p.out + SC_AA), p.in[14]};
      gemm_tile(Lin + 64, 256, (const u16*)(ws + OFF_WAAA), 64, MT, 512, 64, (u >> 2) * 128, (u & 3) * 128, e, smem);
    } else if (t < J2) {
      int u = t - J1;
      EpiStoreBf e{(u16*)(ws + OFF_GG), 512};
      gemm_tile(Lin + 128, 256, (const u16*)(ws + OFF_WGATE), 128, MT, 512, 128, (u >> 2) * 128, (u & 3) * 128, e, smem);
    } else if (t < J3) {
      int u = t - J2;
      EpiQ e{(u16*)(ws + OFF_Q), (const float*)(ws + OFF_ROPE), (const float*)(ws + OFF_ROPE) + LP * 16};
      gemm_tile(Qn, 384, (const u16*)(ws + OFF_WQB), 384, MT, 768, 384, (u / 6) * 128, (u % 6) * 128, e, smem);
    } else if (t < J4) {
      int u = t - J3;
      EpiStoreBf e{(u16*)(ws + OFF_KNP), 512};
      gemm_tile(CbP, 256, (const u16*)(ws + OFF_WKN), 256, TP, 512, 256, (u >> 2) * 128, (u & 3) * 128, e, smem);
    } else if (t < J5) {
      int u = t - J4;
      EpiStoreBf e{(u16*)(ws + OFF_VTP), LDVP};
      gemm_tile((const u16*)(ws + OFF_WV), 256, CbP, 256, 512, TP, 256, (u & 3) * 128, (u >> 2) * 128, e, smem);
    } else if (t < J6) {
      int u = t - J5;
      EpiStoreBf e{(u16*)(ws + OFF_R6), 512};
      gemm_tile(CbS, 256, (const u16*)(ws + OFF_WKN), 256, TKS, 512, 256, (u >> 2) * 128, (u & 3) * 128, e, smem);
    } else {
      int u = t - J6;
      EpiStoreBf e{(u16*)(ws + OFF_VTS), LDVS};
      gemm_tile((const u16*)(ws + OFF_WV), 256, CbS, 256, 512, TKS, 256, (u & 3) * 128, (u >> 2) * 128, e, smem);
    }
  }
}

constexpr int SB_A4 = 0, SB_B4 = 2816, SB_VV = 5632, SB_SIZE = 5712;
constexpr int SB_YP = 2 * SB_SIZE, SB_YPSZ = 64 * 36;
DI float afma(float a, float b, float c) { float r; asm("v_fma_f32 %0, %1, %2, %3" : "=v"(r) : "v"(a), "v"(b), "v"(c)); return r; }
DI float amul(float a, float b) { float r; asm("v_mul_f32 %0, %1, %2" : "=v"(r) : "v"(a), "v"(b)); return r; }
DI void lds_barrier() { asm volatile("s_waitcnt lgkmcnt(0)\n\ts_barrier" ::: "memory"); }
DI float bflo(unsigned u) { return __uint_as_float(u << 16); }
DI float bfhi(unsigned u) { return __uint_as_float(u & 0xFFFF0000u); }
struct ScanRaw { unsigned rs[4], ks[4], av[4]; float2 wv[4]; float inv[4]; float vs; };
__device__ __forceinline__ void scan_item(const Params& p, bool prompt, int b, int h, int grp, float* smem) {
  char* ws = p.ws;
  const int tid = threadIdx.x, lane = tid & 63, wave = tid >> 6;
  const u16* Prkv = (const u16*)(ws + OFF_PRKV);
  const float* Wd = (const float*)(ws + OFF_R2);
  const u16* Aa = (const u16*)((const char*)p.out + SC_AA);
  u16* Yb = (u16*)((char*)p.out + SC_YB);
  const int L = prompt ? LP : 16;
  const int nchunks = L / 16;
  const size_t mbase = prompt ? (size_t)b * LP : (size_t)TP + b * 16;
  const int c2 = lane & 31, ts = lane >> 5;

  if (wave < 2) {
    const int row4 = wave * 2 + ts;
    const int irow = grp * 4 + row4;
    const size_t sidx = (((size_t)b * 8 + h) * 64 + irow) * 64 + c2 * 2;
    float s0 = 0.f, s1 = 0.f;
    if (!prompt) { float2 t = *(const float2*)(p.in[4] + sidx); s0 = t.x; s1 = t.y; }
    lds_barrier();
    for (int c = 0; c < nchunks; ++c) {
      const float* pa = smem + (c & 1) * SB_SIZE + SB_A4 + c2 * 4;
      const float* pb = smem + (c & 1) * SB_SIZE + SB_B4 + c2 * 4;
      const float* pv = smem + (c & 1) * SB_SIZE + SB_VV + row4 * 20;
      float* py = smem + SB_YP + (c & 1) * SB_YPSZ + row4 * 36 + c2;
      float4 Aq[6], Bq[6];
      float4 Vc = *(const float4*)(pv), Vn = *(const float4*)(pv + 4);
#pragma unroll
      for (int i = 0; i < 6; ++i) {
        Aq[i] = *(const float4*)(pa + i * 128); Bq[i] = *(const float4*)(pb + i * 128);
      }
#pragma unroll
      for (int t = 0; t < 16; ++t) {
        const int sl = t % 6, vl = t & 3;
        if (vl == 0 && t > 0) { Vc = Vn; Vn = *(const float4*)(pv + t + 4); }
        const float4 A0 = Aq[sl], B0 = Bq[sl];
        const float v0 = vl == 0 ? Vc.x : (vl == 1 ? Vc.y : (vl == 2 ? Vc.z : Vc.w));
        Aq[sl] = *(const float4*)(pa + (t + 6) * 128); Bq[sl] = *(const float4*)(pb + (t + 6) * 128);
        const float a0 = bflo(__float_as_uint(A0.z)), a1 = bfhi(__float_as_uint(A0.z));
        const float2 R0 = make_float2(bflo(__float_as_uint(A0.w)), bfhi(__float_as_uint(A0.w)));
        float sa = amul(s0, a0) + amul(s1, a1);
        const float d0 = afma(v0, B0.z, amul(s0, A0.x)), d1 = afma(v0, B0.w, amul(s1, A0.y));
        sa = allreduce32(sa);
        s0 = afma(sa, B0.x, d0); s1 = afma(sa, B0.y, d1);
        py[t * 144] = amul(s0, R0.x) + amul(s1, R0.y);
      }
      lds_barrier();
    }
    float* so = p.out + (prompt ? O_STATEP : O_STATES) + sidx;
    *(float2*)so = make_float2(s0, s1);
  } else {
    const int ubeg = wave == 2 ? 0 : 4;
    const int hc = h * 64 + 2 * c2;
    const float2 kkw = *(const float2*)(p.in[16] + hc), kaw = *(const float2*)(p.in[17] + hc);
    const int vr4 = lane & 3, vtt = lane >> 2;
    const int vcol = h * 64 + grp * 4 + vr4;
    const float* PRE8 = (const float*)(ws + OFF_PRE8);
    auto prefetch = [&](ScanRaw& R, int chunk) {
      chunk = chunk < nchunks ? chunk : nchunks - 1;
      const int t0 = chunk * 16;
#pragma unroll
      for (int i = 0; i < 4; ++i) {
        const size_t m = mbase + t0 + 2 * (ubeg + i) + ts;
        const u16* row = Prkv + m * NRKV;
        R.rs[i] = *(const unsigned*)(row + hc); R.ks[i] = *(const unsigned*)(row + 512 + hc);
        R.wv[i] = *(const float2*)(Wd + m * 512 + hc);
        R.av[i] = *(const unsigned*)(Aa + m * 512 + hc);
        R.inv[i] = PRE8[m * 8 + h];
      }
      R.vs = bf2f(Prkv[(mbase + t0 + vtt) * NRKV + 1024 + vcol]);
    };
    auto stage = [&](const ScanRaw& R, float* buf) {
#pragma unroll
      for (int i = 0; i < 4; ++i) {
        const int tt = 2 * (ubeg + i) + ts;
        const float r0 = bflo(R.rs[i]), r1 = bfhi(R.rs[i]);
        const float k0 = bflo(R.ks[i]), k1 = bfhi(R.ks[i]);
        const float a0 = bflo(R.av[i]), a1 = bfhi(R.av[i]);
        const float kk0 = k0 * kkw.x * R.inv[i], kk1 = k1 * kkw.y * R.inv[i];
        const float kt0 = k0 * (1.0f + (a0 - 1.0f) * kaw.x), kt1 = k1 * (1.0f + (a1 - 1.0f) * kaw.y);
        *(float4*)(buf + SB_A4 + (tt * 32 + c2) * 4) = make_float4(R.wv[i].x, R.wv[i].y, __uint_as_float(pack2(-kk0, -kk1)), __uint_as_float(R.rs[i]));
        *(float4*)(buf + SB_B4 + (tt * 32 + c2) * 4) = make_float4(kk0 * a0, kk1 * a1, kt0, kt1);
      }
      if (wave == 3) buf[SB_VV + vr4 * 20 + vtt] = R.vs;
    };
    auto yflush = [&](int chunk) {
      chunk = chunk < 0 ? 0 : chunk;
      const float4* yp = (const float4*)(smem + SB_YP + (chunk & 1) * SB_YPSZ + lane * 36);
      float4 acc = yp[0];
#pragma unroll
      for (int i = 1; i < 8; ++i) { const float4 q = yp[i]; acc.x += q.x; acc.y += q.y; acc.z += q.z; acc.w += q.w; }
      const float y = (acc.x + acc.y) + (acc.z + acc.w);
      Yb[(mbase + chunk * 16 + vtt) * 512 + vcol] = f2bf(y);
    };
    ScanRaw S0, S1;
    prefetch(S0, 0);
    prefetch(S1, 1);
    stage(S0, smem);
    prefetch(S0, 2);
    lds_barrier();
    int c = 0;
    for (; c + 1 < nchunks; c += 2) {
      stage(S1, smem + SB_SIZE);
      prefetch(S1, c + 3);
      if (wave == 2) yflush(c - 1);
      lds_barrier();
      stage(S0, smem);
      prefetch(S0, c + 4);
      if (wave == 2) yflush(c);
      lds_barrier();
    }
    if (wave == 2) yflush(c - 1);
    lds_barrier();
    if (wave == 2) yflush(nchunks - 1);
  }
  __syncthreads();
}

constexpr int KLD = 104;
constexpr int VLD = 68;
constexpr int ATT_BUF = 64 * KLD + 64 * VLD;
__device__ __forceinline__ void attn_item(const u16* __restrict__ Q, int qrow_lim, const u16* __restrict__ Kn, const u16* __restrict__ KR,
                          const u16* __restrict__ Vt, int ldv, int first_valid, int nk_lo, int nk_hi, u16* __restrict__ O,
                          int q_valid, u16* smem) {
  u16* Ks = smem;
  u16* Vs = smem + 64 * KLD;
  const int tid = threadIdx.x, lane = tid & 63, wave = tid >> 6;
  const int r = lane & 31, hh = lane >> 5;
  const int my_nk = wave < 2 ? nk_lo : nk_hi;
  auto ntiles = [&](int nk) { return nk <= first_valid ? 1 : 1 + (nk - first_valid + 63) / 64; };
  const int nt_all = ntiles(nk_hi);
  const int my_nt = (wave * 32 < q_valid) ? ntiles(my_nk) : 0;
  bf16x8 qf[6];
  {
    int qr = wave * 32 + r; qr = qr < qrow_lim ? qr : qrow_lim - 1;
    const u16* qp = Q + (size_t)qr * 768 + hh * 8;
#pragma unroll
    for (int ks = 0; ks < 6; ++ks) qf[ks] = *(const bf16x8*)(qp + ks * 16);
  }
  int kkey[3], kch[3];
#pragma unroll
  for (int i = 0; i < 3; ++i) { int id = tid + 256 * i; kkey[i] = id / 12; kch[i] = id % 12; }
  struct KVRegs { u32x4 rk[3]; u32x4 rv[2]; };
  auto prefetch = [&](KVRegs& R, int kt) {
    int start = kt == 0 ? 0 : first_valid + 64 * (kt - 1);
#pragma unroll
    for (int i = 0; i < 3; ++i) {
      size_t key = (size_t)(start + kkey[i]);
      const u16* src = kch[i] < 8 ? Kn + key * 512 + kch[i] * 8 : KR + key * 32 + (kch[i] - 8) * 8;
      R.rk[i] = *(const u32x4*)src;
    }
#pragma unroll
    for (int i = 0; i < 2; ++i) {
      int id = tid + 256 * i; int d = id >> 3, ch = id & 7;
      R.rv[i] = *(const u32x4*)(Vt + (size_t)d * ldv + start + ch * 8);
    }
  };
  auto lds_write = [&](const KVRegs& R, int buf) {
    u16* Kb = Ks + buf * ATT_BUF;
    u16* Vb = Vs + buf * ATT_BUF;
#pragma unroll
    for (int i = 0; i < 3; ++i) *(u32x4*)(Kb + kkey[i] * KLD + kch[i] * 8) = R.rk[i];
#pragma unroll
    for (int i = 0; i < 2; ++i) {
      int id = tid + 256 * i; int d = id >> 3, ch = id & 7;
      u32x2* dst = (u32x2*)(Vb + d * VLD + ch * 8);
      u32x2 t0 = {R.rv[i].x, R.rv[i].y}, t1 = {R.rv[i].z, R.rv[i].w};
      dst[0] = t0;
      dst[1] = t1;
    }
  };
  f32x16 o[2];
#pragma unroll
  for (int i = 0; i < 2; ++i)
#pragma unroll
    for (int e = 0; e < 16; ++e) o[i][e] = 0.f;
  float m_run = -1e30f, l_run = 0.f;
  auto compute = [&](int kt) {
    const u16* Kb = Ks + (kt & 1) * ATT_BUF;
    const u16* Vb = Vs + (kt & 1) * ATT_BUF;
    const int start = kt == 0 ? 0 : first_valid + 64 * (kt - 1);
    int tv = kt == 0 ? first_valid : 64;
    if (my_nk - start < tv) tv = my_nk - start;
    f32x16 s[2];
#pragma unroll
    for (int T = 0; T < 2; ++T)
#pragma unroll
      for (int e = 0; e < 16; ++e) s[T][e] = 0.f;
#pragma unroll
    for (int ks = 0; ks < 6; ++ks) {
#pragma unroll
      for (int T = 0; T < 2; ++T) {
        bf16x8 kf = *(const bf16x8*)(Kb + (T * 32 + r) * KLD + ks * 16 + hh * 8);
        s[T] = MFMA32(kf, qf[ks], s[T]);
      }
    }
    if (tv < 64) {
#pragma unroll
      for (int T = 0; T < 2; ++T)
#pragma unroll
        for (int e = 0; e < 16; ++e) {
          int kidx = T * 32 + (e & 3) + 8 * (e >> 2) + 4 * hh;
          if (kidx >= tv) s[T][e] = -1e30f;
        }
    }
    float mx = s[0][0];
#pragma unroll
    for (int T = 0; T < 2; ++T)
#pragma unroll
      for (int e = 0; e < 16; ++e) mx = fmaxf(mx, s[T][e]);
    mx = fmaxf(mx, __shfl_xor(mx, 32));
    const float m_new = fmaxf(m_run, mx);
    const float alpha = __builtin_amdgcn_exp2f(m_run - m_new);
    m_run = m_new;
    float rsum = 0.f;
#pragma unroll
    for (int T = 0; T < 2; ++T)
#pragma unroll
      for (int e = 0; e < 16; ++e) { float pv = __builtin_amdgcn_exp2f(s[T][e] - m_new); s[T][e] = pv; rsum += pv; }
    l_run = l_run * alpha + rsum;
#pragma unroll
    for (int i = 0; i < 2; ++i)
#pragma unroll
      for (int e = 0; e < 16; ++e) o[i][e] *= alpha;
#pragma unroll
    for (int T = 0; T < 2; ++T)
#pragma unroll
      for (int ss = 0; ss < 2; ++ss) {
        uint4 pk;
        pk.x = pack2(s[T][8 * ss + 0], s[T][8 * ss + 1]);
        pk.y = pack2(s[T][8 * ss + 2], s[T][8 * ss + 3]);
        pk.z = pack2(s[T][8 * ss + 4], s[T][8 * ss + 5]);
        pk.w = pack2(s[T][8 * ss + 6], s[T][8 * ss + 7]);
        bf16x8 pf = __builtin_bit_cast(bf16x8, pk);
#pragma unroll
        for (int dt = 0; dt < 2; ++dt) {
          const u16* vp = Vb + (dt * 32 + r) * VLD + 32 * T + 16 * ss + 4 * hh;
          uint2 lo = *(const uint2*)vp;
          uint2 hi = *(const uint2*)(vp + 8);
          uint4 vv = make_uint4(lo.x, lo.y, hi.x, hi.y);
          o[dt] = MFMA32(__builtin_bit_cast(bf16x8, vv), pf, o[dt]);
        }
      }
  };
  KVRegs RA, RB;
  prefetch(RA, 0);
  if (1 < nt_all) prefetch(RB, 1);
  lds_write(RA, 0);
  __syncthreads();
  for (int kt = 0; kt < nt_all; kt += 2) {
    if (kt + 2 < nt_all) prefetch(RA, kt + 2);
    if (kt < my_nt) compute(kt);
    if (kt + 1 < nt_all) lds_write(RB, 1);
    __syncthreads();
    if (kt + 1 < nt_all) {
      if (kt + 3 < nt_all) prefetch(RB, kt + 3);
      if (kt + 1 < my_nt) compute(kt + 1);
      if (kt + 2 < nt_all) lds_write(RA, 0);
      __syncthreads();
    }
  }
  if (my_nt > 0) {
    float l = l_run + __shfl_xor(l_run, 32);
    float inv = 1.0f / l;
    int qr = wave * 32 + r;
    if (qr < q_valid) {
#pragma unroll
      for (int dt = 0; dt < 2; ++dt)
#pragma unroll
        for (int g = 0; g < 4; ++g) {
          uint2 st;
          st.x = pack2(o[dt][4 * g + 0] * inv, o[dt][4 * g + 1] * inv);
          st.y = pack2(o[dt][4 * g + 2] * inv, o[dt][4 * g + 3] * inv);
          *(uint2*)(O + (size_t)qr * 512 + dt * 32 + 8 * g + 4 * hh) = st;
        }
    }
  }
  __syncthreads();
}

__device__ __forceinline__ void phase_mixers(const Params& p, char* smem) {
  char* ws = p.ws;
#ifndef SUBM
#define SUBM 3
#endif
  if (SUBM & 1) {
    for (int it = blockIdx.x; it < 2048; it += gridDim.x) scan_item(p, false, it >> 7, (it >> 4) & 7, it & 15, (float*)smem);
    for (int it = blockIdx.x; it < 256; it += gridDim.x) scan_item(p, true, it >> 7, (it >> 4) & 7, it & 15, (float*)smem);
  }
  if (SUBM & 2) {
    int* cnt = (int*)(ws + OFF_CNT);
    int* sitem = (int*)(smem + 81472);
    const u16* Q = (const u16*)(ws + OFF_Q);
    u16* Oat = (u16*)((char*)p.out + SC_OAT);
    constexpr int NITEMS = 128 + 1024 + 16;
    for (;;) {
      if (threadIdx.x == 0) *sitem = atomicAdd(cnt, 1);
      __syncthreads();
      const int it = *sitem;
      __syncthreads();
      if (it >= NITEMS) break;
      size_t q0, k0; int h, ldv, fv, nlo, nhi, qv;
      const u16 *kn, *kr, *vt;
      if (it < 128) {
        int b = it >> 3; h = it & 7;
        q0 = (size_t)TP + b * 16; k0 = (size_t)b * LKS;
        kn = (const u16*)(ws + OFF_R6); kr = (const u16*)(ws + OFF_KRS); vt = (const u16*)(ws + OFF_VTS);
        ldv = LDVS; fv = 64; nlo = LKS; nhi = LKS; qv = 16;
      } else {
        kn = (const u16*)(ws + OFF_KNP); kr = (const u16*)(ws + OFF_KRP); vt = (const u16*)(ws + OFF_VTP);
        ldv = LDVP; fv = 16;
        if (it < 1152) {
          int j = it - 128;
          int qb = 63 - (j >> 4), b = (j >> 3) & 1; h = j & 7;
          k0 = (size_t)b * LP; q0 = k0 + 16 + 128 * qb;
          nlo = 16 + 64 * (2 * qb + 1); nhi = 16 + 64 * (2 * qb + 2); qv = 128;
        } else {
          int j = it - 1152;
          int b = j >> 3; h = j & 7;
          k0 = (size_t)b * LP; q0 = k0;
          nlo = 16; nhi = 16; qv = 16;
        }
      }
      attn_item(Q + q0 * 768 + h * 96, MT - (int)q0, kn + k0 * 512 + h * 64, kr + k0 * 32, vt + (size_t)(h * 64) * ldv + k0, ldv, fv,
                nlo, nhi, Oat + q0 * 512 + h * 64, qv, (u16*)smem);
    }
  }
}

__device__ __forceinline__ void phase_postmix(const Params& p) {
  char* ws = p.ws;
  const int lane = threadIdx.x & 63, wave = threadIdx.x >> 6;
  const u16* Prkv = (const u16*)(ws + OFF_PRKV);
  const u16* Aa = (const u16*)((const char*)p.out + SC_AA);
  const u16* Yb = (const u16*)((const char*)p.out + SC_YB);
  const u16* Oat = (const u16*)((const char*)p.out + SC_OAT);
  const u16* Gg = (const u16*)(ws + OFF_GG);
  u16* Ocat = (u16*)(ws + OFF_OCAT);
  const float* mu_shift = p.in[10];
  const float* k_a = p.in[17]; const float* r_k = p.in[18]; const float* gn_g = p.in[19]; const float* gn_b = p.in[20];
  const float* og = p.in[25];
  for (int m2 = blockIdx.x * 4 + wave; m2 < M2; m2 += gridDim.x * 4) {
    const bool prompt = m2 < 16384;
    const int m = prompt ? ((m2 >> 13) * LP + 16 + (m2 & 8191)) : (TP + m2 - 16384);
    const bool first = (!prompt) && (((m2 - 16384) & 15) == 0);
    const float* ss = p.in[5] + (size_t)(prompt ? 0 : ((m2 - 16384) >> 4)) * CR;
    const u16* row = Prkv + (size_t)m * NRKV;
#pragma unroll 4
    for (int h = 0; h < 8; ++h) {
      int col = h * 64 + lane;
      float y = bf2f(Yb[(size_t)m * 512 + col]);
      float mu = wave_sum(y) * (1.0f / 64.0f);
      float d = y - mu;
      float var = wave_sum(d * d) * (1.0f / 64.0f);
      float yn = d * rsqrtf(var + 64e-5f) * gn_g[col] + gn_b[col];
      const float r = bf2f(row[col]), k = bf2f(row[512 + col]), v = bf2f(row[1024 + col]);
      float a = bf2f(Aa[(size_t)m * 512 + col]);
      float kt = k * (1.0f + (a - 1.0f) * k_a[col]);
      float bs = wave_sum(r * kt * r_k[col]);
      float o = (yn + bs * v) * bf2f(Gg[(size_t)m * 512 + col]);
      Ocat[(size_t)m2 * 1024 + col] = f2bf(o);
    }
    float v[8]; float sq = 0.f;
#pragma unroll
    for (int i = 0; i < 8; ++i) { v[i] = bf2f(Oat[(size_t)m * 512 + lane + 64 * i]); sq += v[i] * v[i]; }
    float rs = rsqrtf(wave_sum(sq) * (1.0f / 512.0f) + 1e-6f);
#pragma unroll
    for (int i = 0; i < 8; ++i) Ocat[(size_t)m2 * 1024 + 512 + lane + 64 * i] = f2bf(v[i] * rs * og[lane + 64 * i]);
  }
}

__device__ __forceinline__ void phase_ln(const Params& p, const float* g, const float* b, u16* hb, float oscale) {
  const int lane = threadIdx.x & 63, wave = threadIdx.x >> 6;
  const int stride = gridDim.x * 4;
  for (int m2 = blockIdx.x * 4 + wave; m2 < M2; m2 += 2 * stride) {
    const int mB = m2 + stride;
    const bool hasB = mB < M2;
    float* rowA = p.out + (size_t)m2 * 1024;
    float* rowB = p.out + (size_t)(hasB ? mB : m2) * 1024;
    float4 va[4], vb[4];
#pragma unroll
    for (int i = 0; i < 4; ++i) { va[i] = *(const float4*)(rowA + lane * 4 + 256 * i); vb[i] = *(const float4*)(rowB + lane * 4 + 256 * i); }
    float sa = 0.f, sb = 0.f;
#pragma unroll
    for (int i = 0; i < 4; ++i) { sa += va[i].x + va[i].y + va[i].z + va[i].w; sb += vb[i].x + vb[i].y + vb[i].z + vb[i].w; }
    const float muA = wave_sum(sa) * (1.0f / 1024.0f), muB = wave_sum(sb) * (1.0f / 1024.0f);
    float qa = 0.f, qb = 0.f;
#pragma unroll
    for (int i = 0; i < 4; ++i) {
      float a0 = va[i].x - muA, a1 = va[i].y - muA, a2 = va[i].z - muA, a3 = va[i].w - muA;
      float b0 = vb[i].x - muB, b1 = vb[i].y - muB, b2 = vb[i].z - muB, b3 = vb[i].w - muB;
      qa += a0 * a0 + a1 * a1 + a2 * a2 + a3 * a3;
      qb += b0 * b0 + b1 * b1 + b2 * b2 + b3 * b3;
    }
    const float rsA = rsqrtf(wave_sum(qa) * (1.0f / 1024.0f) + 1e-5f), rsB = rsqrtf(wave_sum(qb) * (1.0f / 1024.0f) + 1e-5f);
#pragma unroll
    for (int i = 0; i < 4; ++i) {
      int c = lane * 4 + 256 * i;
      float4 gg = *(const float4*)(g + c), b4 = *(const float4*)(b + c);
      float4 o;
      o.x = (va[i].x - muA) * rsA * gg.x + b4.x; o.y = (va[i].y - muA) * rsA * gg.y + b4.y;
      o.z = (va[i].z - muA) * rsA * gg.z + b4.z; o.w = (va[i].w - muA) * rsA * gg.w + b4.w;
      *(float4*)(rowA + c) = make_float4(o.x * oscale, o.y * oscale, o.z * oscale, o.w * oscale);
      if (hb) { uint2 t; t.x = pack2(o.x, o.y); t.y = pack2(o.z, o.w); *(uint2*)(hb + (size_t)m2 * 1024 + c) = t; }
      if (hasB) {
        o.x = (vb[i].x - muB) * rsB * gg.x + b4.x; o.y = (vb[i].y - muB) * rsB * gg.y + b4.y;
        o.z = (vb[i].z - muB) * rsB * gg.z + b4.z; o.w = (vb[i].w - muB) * rsB * gg.w + b4.w;
        *(float4*)(rowB + c) = make_float4(o.x * oscale, o.y * oscale, o.z * oscale, o.w * oscale);
        if (hb) { uint2 t; t.x = pack2(o.x, o.y); t.y = pack2(o.z, o.w); *(uint2*)(hb + (size_t)mB * 1024 + c) = t; }
      }
    }
  }
}

DI void fast_barrier(unsigned* word) {
  asm volatile("s_waitcnt vmcnt(0) lgkmcnt(0)" ::: "memory");
  __syncthreads();
  if (threadIdx.x == 0) {
    __builtin_amdgcn_fence(__ATOMIC_RELEASE, "agent");
    asm volatile("s_waitcnt vmcnt(0)" ::: "memory");
    __hip_atomic_fetch_add(word, 1u, __ATOMIC_RELAXED, __HIP_MEMORY_SCOPE_AGENT);
    const unsigned target = gridDim.x;
    unsigned spins = 0;
    while (__hip_atomic_load(word, __ATOMIC_RELAXED, __HIP_MEMORY_SCOPE_AGENT) < target) {
      __builtin_amdgcn_s_sleep(2);
      if (++spins > (1u << 24)) break;
    }
    __builtin_amdgcn_fence(__ATOMIC_ACQUIRE, "agent");
    asm volatile("s_waitcnt vmcnt(0)" ::: "memory");
  }
  __syncthreads();
}

#define XB_TMO      128
#define XB_XCNT(j)  (256  + 64 * (j))
#define XB_XSUB(j)  (1280 + 64 * (j))
#define XB_XGEN(j)  (2304 + 64 * (j))
#define XB_TOP      3328
#define XB_TOPGEN   3392
#define XB_SPIN_CAP (1u << 20)
DI unsigned xb_ld(unsigned* p) { return __hip_atomic_load(p, __ATOMIC_RELAXED, __HIP_MEMORY_SCOPE_AGENT); }
DI unsigned xb_add(unsigned* p, unsigned v) { return __hip_atomic_fetch_add(p, v, __ATOMIC_RELAXED, __HIP_MEMORY_SCOPE_AGENT); }
DI unsigned xb_xcc_id() { return (unsigned)__builtin_amdgcn_s_getreg((3 << 11) | 20) & 0xFu; }
#define XB_SPIN(cond, bar) do { unsigned _sp = 0; while (cond) { __builtin_amdgcn_s_sleep(1); \
    if ((++_sp & 255u) == 0u) { if (xb_ld(&(bar)[XB_TMO])) break; if (_sp > XB_SPIN_CAP) { atomicAdd(&(bar)[XB_TMO], 1u); break; } } } } while (0)
struct XcdBarrier { unsigned* bar; unsigned x; volatile unsigned* st; };
DI XcdBarrier xcd_barrier_post(unsigned* bar, volatile unsigned* st) {
  XcdBarrier b; b.bar = bar; b.x = xb_xcc_id(); b.st = st;
  if (threadIdx.x == 0) (void)xb_add(&bar[XB_XCNT(b.x)], 1u);
  return b;
}
DI void xcd_barrier_complete(unsigned* bar, unsigned x, unsigned& nloc, unsigned& nx) {
  const unsigned G = gridDim.x;
  unsigned sum, cnt, mine, sp = 0u;
  for (;;) {
    sum = 0u; cnt = 0u; mine = 0u;
#pragma unroll
    for (unsigned j = 0; j < 16; ++j) { const unsigned c = xb_ld(&bar[XB_XCNT(j)]); sum += c; cnt += (c > 0u) ? 1u : 0u; mine = (j == x) ? c : mine; }
    if (sum == G) break;
    __builtin_amdgcn_s_sleep(1);
    if ((++sp & 255u) == 0u) { if (xb_ld(&bar[XB_TMO])) break; if (sp > XB_SPIN_CAP) { atomicAdd(&bar[XB_TMO], 1u); break; } }
  }
  nloc = mine > 0u ? mine : 1u; nx = cnt > 0u ? cnt : 1u;
}
DI void xcd_barrier(const XcdBarrier& b) {
  asm volatile("s_waitcnt vmcnt(0)" ::: "memory");
  __syncthreads();
  if (threadIdx.x == 0) {
    unsigned* bar = b.bar;
    __builtin_amdgcn_s_waitcnt(0);
    unsigned nloc = b.st[0], nx = b.st[1];
    if (nloc == 0u) { xcd_barrier_complete(bar, b.x, nloc, nx); b.st[0] = nloc; b.st[1] = nx; }
    const unsigned old = xb_add(&bar[XB_XSUB(b.x)], 1u);
    const unsigned gen = old / nloc;
    if (old + 1u == (gen + 1u) * nloc) {
      __builtin_amdgcn_fence(__ATOMIC_RELEASE, "agent");
      asm volatile("s_waitcnt vmcnt(0)" ::: "memory");
      const unsigned og = xb_add(&bar[XB_TOP], 1u);
      const unsigned tg = og / nx;
      if (og + 1u == (tg + 1u) * nx) xb_add(&bar[XB_TOPGEN], 1u);
      else XB_SPIN(xb_ld(&bar[XB_TOPGEN]) == tg, bar);
      __builtin_amdgcn_fence(__ATOMIC_ACQUIRE, "agent");
      xb_add(&bar[XB_XGEN(b.x)], 1u);
      asm volatile("s_waitcnt vmcnt(0)" ::: "memory");
    } else {
      XB_SPIN(xb_ld(&bar[XB_XGEN(b.x)]) == gen, bar);
      __builtin_amdgcn_fence(__ATOMIC_ACQUIRE, "agent");
      asm volatile("s_waitcnt vmcnt(0)" ::: "memory");
    }
  }
  __syncthreads();
}

__global__ void __launch_bounds__(256, 2) fwd_megakernel(Params p) {
  __shared__ __attribute__((aligned(16))) char smem[SMEM_BYTES];
  cg::grid_group grid = cg::this_grid();
  char* ws = p.ws;
  unsigned* bar = (unsigned*)(ws + OFF_CNT);

#ifndef PHM
#define PHM 0xFFFF
#endif
  volatile unsigned* xst = (volatile unsigned*)(smem + 81472 + 16);
  if (threadIdx.x == 0) { xst[0] = 0u; xst[1] = 0u; }
  __syncthreads();
  const XcdBarrier xbar = xcd_barrier_post((unsigned*)(ws + OFF_XB), xst);
  if (PHM & 1) phase_prep(p, smem);
  if (p.ws == nullptr) grid.sync();
  xcd_barrier(xbar);
  if (PHM & 2) {
    EpiInproj e{(u16*)(ws + OFF_PRKV), (u16*)(ws + OFF_R6), p.out};
    constexpr int TM = (MT + 127) / 128, TN = (CIN + 127) / 128;
    gemm_phase((const u16*)(ws + OFF_R2), 1024, (const u16*)(ws + OFF_WIN), 1024, MT, CIN, 1024, TM * TN,
               [](int t, int& m0, int& n0) { m0 = (t / TN) * 128; n0 = (t % TN) * 128; }, e, (u16*)smem);
  }
  xcd_barrier(xbar);
  if (PHM & 4) phase_postproj(p);
  {
    ShiftSave sv;
    shift_save(p, sv);
    xcd_barrier(xbar);
    shift_apply(p, sv);
  }
  if (PHM & 8) phase_gemms3(p, (u16*)smem);
  xcd_barrier(xbar);
  if (PHM & 16) phase_mixers(p, smem);
  xcd_barrier(xbar);
  if (PHM & 32) phase_postmix(p);
  xcd_barrier(xbar);
  if (PHM & 64) {
    EpiOut e{p.in[0], p.in[1], (const float*)(ws + OFF_STATS), p.in[7], p.in[8], p.out};
    gemm_phase((const u16*)(ws + OFF_OCAT), 1024, (const u16*)(ws + OFF_WOUT), 1024, M2, 1024, 1024, 130 * 8,
               [](int t, int& m0, int& n0) { m0 = (t >> 3) * 128; n0 = (t & 7) * 128; }, e, (u16*)smem);
  }
  xcd_barrier(xbar);
  if (PHM & 128) phase_ln(p, p.in[27], p.in[28], (u16*)(ws + OFF_H1B), ALPHA);
  xcd_barrier(xbar);
  if (PHM & 256) {
    EpiUp e{(u16*)(ws + OFF_ACT)};
    gemm_phase((const u16*)(ws + OFF_H1B), 1024, (const u16*)(ws + OFF_WUP), 1024, M2, 4096, 1024, 130 * 32,
               [](int t, int& m0, int& n0) { m0 = (t >> 5) * 128; n0 = (t & 31) * 128; }, e, (u16*)smem);
  }
  xcd_barrier(xbar);
  if (PHM & 512) {
    EpiDown e{p.out};
    const int G = gridDim.x, NT = 130 * 8;
    const int full = (NT / G) * G, left = NT - full;
    const int pieces = left > 0 ? G / left : 0;
    const bool split = left > 0 && pieces >= 2 && pieces <= 64 && (64 % pieces) == 0 && pieces * left == G;
    for (int t = blockIdx.x; t < (split ? full : NT); t += gridDim.x)
      gemm_tile((const u16*)(ws + OFF_ACT), 4096, (const u16*)(ws + OFF_WDOWN), 4096, M2, 1024, 4096, (t >> 3) * 128, (t & 7) * 128, e,
                (u16*)smem);
    if (split) {
      EpiDownAtomic ea{p.out};
      const int t = full + (int)blockIdx.x / pieces, pc = (int)blockIdx.x % pieces, klen = 4096 / pieces;
      gemm_tile((const u16*)(ws + OFF_ACT), 4096, (const u16*)(ws + OFF_WDOWN), 4096, M2, 1024, klen, (t >> 3) * 128, (t & 7) * 128, ea,
                (u16*)smem, pc * klen);
    }
  }
  xcd_barrier(xbar);
  if (PHM & 1024) phase_ln(p, p.in[31], p.in[32], nullptr, 1.0f);
}

extern "C" void kernel_launch(void* const* d_in, const int* in_sizes, int n_in, void* d_out, int out_size, void* d_ws,
                              size_t ws_size, hipStream_t stream) {
  static int grid_blocks = 0;
  if (!grid_blocks) {
    int dev = 0, cus = 0, per_cu = 0;
    hipGetDevice(&dev);
    hipDeviceGetAttribute(&cus, hipDeviceAttributeMultiprocessorCount, dev);
    hipOccupancyMaxActiveBlocksPerMultiprocessor(&per_cu, (const void*)fwd_megakernel, 256, 0);
    if (per_cu > 2) per_cu = 2;
    if (per_cu < 1) per_cu = 1;
    grid_blocks = cus * per_cu;
  }
  Params p{};
  for (int i = 0; i < 33; ++i) p.in[i] = (const float*)d_in[i];
  p.out = (float*)d_out;
  p.ws = (char*)d_ws;
  hipMemsetAsync((char*)d_ws + OFF_CNT, 0, 8192, stream);
  hipMemsetAsync((char*)d_ws + OFF_XB, 0, 16384, stream);
  void* args[] = {&p};
  hipError_t e = hipLaunchCooperativeKernel((const void*)fwd_megakernel, dim3(grid_blocks), dim3(256), args, 0, stream);
  if (e != hipSuccess) fprintf(stderr, "cooperative launch failed: %s (grid %d)\n", hipGetErrorString(e), grid_blocks);
}
```

```cpp
#include <hip/hip_runtime.h>
#include <hip/hip_cooperative_groups.h>
#include <cstdio>
namespace cg = cooperative_groups;

typedef unsigned short u16;
typedef __attribute__((ext_vector_type(8))) short bf16x8;
typedef __attribute__((ext_vector_type(16))) float f32x16;
typedef __attribute__((ext_vector_type(2))) float f32x2;
typedef __attribute__((ext_vector_type(4))) unsigned u32x4;
typedef __attribute__((ext_vector_type(2))) unsigned u32x2;
typedef __attribute__((ext_vector_type(2))) __bf16 bf16x2_t;

#define DI __device__ __forceinline__
#define MFMA32(a, b, c) __builtin_amdgcn_mfma_f32_32x32x16_bf16((a), (b), (c), 0, 0, 0)

constexpr int D_ = 1024;
constexpr int LP = 8208;
constexpr int TP = 16416;
constexpr int TS = 256;
constexpr int MT = TP + TS;
constexpr int M2 = 16640;
constexpr int LKS = 2064;
constexpr int TKS = 16 * LKS;
constexpr int CR = 1792;
constexpr int CIN = 2464;
constexpr int NRKV = 1536;
constexpr int NREST = 928;
constexpr int LDVP = TP + 64;
constexpr int LDVS = TKS + 64;

constexpr size_t OFF_WIN = 0;
constexpr size_t OFF_WQB = OFF_WIN + (size_t)CIN * 1024 * 2;
constexpr size_t OFF_WKN = OFF_WQB + (size_t)768 * 384 * 2;
constexpr size_t OFF_WV = OFF_WKN + (size_t)512 * 256 * 2;
constexpr size_t OFF_WDEC = OFF_WV + (size_t)512 * 256 * 2;
constexpr size_t OFF_WAAA = OFF_WDEC + (size_t)512 * 64 * 2;
constexpr size_t OFF_WGATE = OFF_WAAA + (size_t)512 * 64 * 2;
constexpr size_t OFF_WOUT = OFF_WGATE + (size_t)512 * 128 * 2;
constexpr size_t OFF_WUP = OFF_WOUT + (size_t)1024 * 1024 * 2;
constexpr size_t OFF_WDOWN = OFF_WUP + (size_t)4096 * 1024 * 2;
constexpr size_t OFF_PRKV = OFF_WDOWN + (size_t)4096 * 1024 * 2;
constexpr size_t OFF_R2 = OFF_PRKV + (size_t)MT * NRKV * 2;
constexpr size_t OFF_GG = OFF_R2 + (size_t)MT * 1024 * 2;
constexpr size_t OFF_Q = OFF_GG + (size_t)MT * 512 * 2;
constexpr size_t OFF_KNP = OFF_Q + (size_t)MT * 768 * 2;
constexpr size_t OFF_VTP = OFF_KNP + (size_t)(TP + 64) * 512 * 2;
constexpr size_t OFF_R6 = OFF_VTP + (size_t)512 * LDVP * 2;
constexpr size_t OFF_VTS = OFF_R6 + (size_t)(TKS + 64) * 512 * 2;
constexpr size_t OFF_KRP = OFF_VTS + (size_t)512 * LDVS * 2;
constexpr size_t OFF_KRS = OFF_KRP + (size_t)(TP + 64) * 32 * 2;
constexpr size_t OFF_ROPE = OFF_KRS + (size_t)(TKS + 64) * 32 * 2;
constexpr size_t OFF_STATS = OFF_ROPE + (size_t)LP * 16 * 4 * 2;
constexpr size_t OFF_CNT = OFF_STATS + (size_t)MT * 2 * 4;
constexpr size_t OFF_PRE8 = OFF_CNT + 8192;
constexpr size_t OFF_XB = OFF_PRE8 + (size_t)MT * 8 * 4;
constexpr size_t WS_END = OFF_XB + 16384;
static_assert(WS_END < (size_t)256 * 1024 * 1024, "ws overflow");
constexpr size_t OFF_OCAT = OFF_R6;
constexpr size_t OFF_H1B = OFF_PRKV;
constexpr size_t OFF_ACT = OFF_R2;
static_assert(OFF_ACT + (size_t)M2 * 4096 * 2 < (size_t)256 * 1024 * 1024, "act overflow");
static_assert((size_t)M2 * 1024 * 2 <= (size_t)MT * NRKV * 2, "h1b overflow");

constexpr size_t SC_AA = 0;
constexpr size_t SC_LIN = SC_AA + (size_t)MT * 512 * 2;
constexpr size_t SC_QN = SC_LIN + (size_t)MT * 256 * 2;
constexpr size_t SC_CBP = SC_QN + (size_t)MT * 384 * 2;
constexpr size_t SC_CBS = SC_CBP + (size_t)TP * 256 * 2;
constexpr size_t SC_END = SC_CBS + (size_t)TKS * 256 * 2;
static_assert(SC_END <= (size_t)2 * 8192 * 1024 * 4, "scratch overflow");
constexpr size_t SC_YB = SC_LIN;
constexpr size_t SC_OAT = SC_CBP;
static_assert(SC_YB + (size_t)MT * 512 * 2 <= SC_CBP, "yb overflow");
static_assert(SC_OAT + (size_t)MT * 512 * 2 <= SC_END, "oat overflow");

constexpr size_t O_Y = 0;
constexpr size_t O_LATP = (size_t)M2 * 1024;
constexpr size_t O_ROPEP = O_LATP + (size_t)TP * 256;
constexpr size_t O_STATEP = O_ROPEP + (size_t)TP * 32;
constexpr size_t O_SHIFTP = O_STATEP + (size_t)2 * 8 * 64 * 64;
constexpr size_t O_LATS = O_SHIFTP + (size_t)2 * CR;
constexpr size_t O_ROPES = O_LATS + (size_t)TS * 256;
constexpr size_t O_STATES = O_ROPES + (size_t)TS * 32;
constexpr size_t O_SHIFTS = O_STATES + (size_t)16 * 8 * 64 * 64;

constexpr float ALPHA = 1.189207115002721f;
constexpr float DECAY_SCALE = 0.6065306597126334f;
constexpr float QSCALE = 0.10206207261596577f * 1.4426950408889634f;

constexpr int SMEM_BYTES = 81472 + 64;

struct Params {
  const float* in[33];
  float* out;
  char* ws;
};

DI u16 f2bf(float f) { unsigned u = __float_as_uint(f); u += 0x7FFFu + ((u >> 16) & 1u); return (u16)(u >> 16); }
DI float bf2f(u16 h) { return __uint_as_float(((unsigned)h) << 16); }
DI unsigned pack2(float a, float b) {
  f32x2 v = {a, b};
  bf16x2_t r = __builtin_convertvector(v, bf16x2_t);
  return __builtin_bit_cast(unsigned, r);
}
template <int CTRL> DI float dppf(float x) {
  return __int_as_float(__builtin_amdgcn_mov_dpp(__float_as_int(x), CTRL, 0xF, 0xF, true));
}
DI float allreduce16(float x) {
  x += dppf<0xB1>(x);
  x += dppf<0x4E>(x);
  x += dppf<0x141>(x);
  x += dppf<0x140>(x);
  return x;
}
DI float allreduce32(float x) {
  x = allreduce16(x);
  auto t = __builtin_amdgcn_permlane16_swap(__float_as_uint(x), __float_as_uint(x), false, false);
  return __uint_as_float(t[0]) + __uint_as_float(t[1]);
}
DI float wave_sum(float x) {
  x = allreduce32(x);
  auto t = __builtin_amdgcn_permlane32_swap(__float_as_uint(x), __float_as_uint(x), false, false);
  return __uint_as_float(t[0]) + __uint_as_float(t[1]);
}
DI float sigmoidf_(float x) { return 1.0f / (1.0f + __expf(-x)); }
DI float tanhf_(float x) { float e = __expf(2.0f * x); return 1.0f - 2.0f / (e + 1.0f); }

constexpr int GLD = 72;
constexpr int GBUF = 256 * GLD;
template <class Epi>
__device__ __forceinline__ void gemm_tile(const u16* __restrict__ A, int lda, const u16* __restrict__ Bt, int ldb,
                          int M, int N, int K, int m0, int n0, Epi& epi, u16* smem, int kbeg = 0) {
  u16* As = smem;
  u16* Bs = smem + 128 * GLD;
  const int tid = threadIdx.x, lane = tid & 63, wave = tid >> 6;
  const int wm = wave >> 1, wn = wave & 1;
  const int r = lane & 31, hh = lane >> 5;
  size_t aoff[4], boff[4];
  int soff[4];
#pragma unroll
  for (int i = 0; i < 4; ++i) {
    int c = tid + 256 * i;
    int row = c >> 3, kc = c & 7;
    int ar = m0 + row; ar = ar < M ? ar : M - 1;
    int br = n0 + row; br = br < N ? br : N - 1;
    aoff[i] = (size_t)ar * lda + kc * 8 + kbeg;
    boff[i] = (size_t)br * ldb + kc * 8 + kbeg;
    soff[i] = row * GLD + kc * 8;
  }
  struct GRegs { u32x4 a[4], b[4]; };
  auto prefetch = [&](GRegs& R, int kt) {
#pragma unroll
    for (int i = 0; i < 4; ++i) {
      R.a[i] = *(const u32x4*)(A + aoff[i] + (size_t)kt * 64);
      R.b[i] = *(const u32x4*)(Bt + boff[i] + (size_t)kt * 64);
    }
  };
  auto lds_write = [&](const GRegs& R, int buf) {
#pragma unroll
    for (int i = 0; i < 4; ++i) {
      *(u32x4*)(As + buf * GBUF + soff[i]) = R.a[i];
      *(u32x4*)(Bs + buf * GBUF + soff[i]) = R.b[i];
    }
  };
  f32x16 acc[2][2];
#pragma unroll
  for (int i = 0; i < 2; ++i)
#pragma unroll
    for (int j = 0; j < 2; ++j)
#pragma unroll
      for (int e = 0; e < 16; ++e) acc[i][j][e] = 0.f;
  auto compute = [&](int buf) {
    const u16* Ab = As + buf * GBUF;
    const u16* Bb = Bs + buf * GBUF;
#pragma unroll
    for (int ks = 0; ks < 4; ++ks) {
      bf16x8 af[2], bfr[2];
#pragma unroll
      for (int i = 0; i < 2; ++i) {
        af[i] = *(const bf16x8*)(Ab + (wm * 64 + i * 32 + r) * GLD + ks * 16 + hh * 8);
        bfr[i] = *(const bf16x8*)(Bb + (wn * 64 + i * 32 + r) * GLD + ks * 16 + hh * 8);
      }
#pragma unroll
      for (int i = 0; i < 2; ++i)
#pragma unroll
        for (int j = 0; j < 2; ++j) acc[i][j] = MFMA32(af[i], bfr[j], acc[i][j]);
    }
  };
  const int nk = K >> 6;
  GRegs RA, RB;
  prefetch(RA, 0);
  if (1 < nk) prefetch(RB, 1);
  lds_write(RA, 0);
  __syncthreads();
  for (int kt = 0; kt < nk; kt += 2) {
    if (kt + 2 < nk) prefetch(RA, kt + 2);
    compute(0);
    if (kt + 1 < nk) lds_write(RB, 1);
    __syncthreads();
    if (kt + 1 < nk) {
      if (kt + 3 < nk) prefetch(RB, kt + 3);
      compute(1);
      if (kt + 2 < nk) lds_write(RA, 0);
      __syncthreads();
    }
  }
#pragma unroll
  for (int i = 0; i < 2; ++i)
#pragma unroll
    for (int j = 0; j < 2; ++j) {
      const int col = n0 + wn * 64 + j * 32 + r;
#pragma unroll
      for (int e = 0; e < 16; ++e) {
        const int row = m0 + wm * 64 + i * 32 + (e & 3) + 8 * (e >> 2) + 4 * hh;
        epi(row, col, acc[i][j][e], (row < M) && (col < N));
      }
    }
}

template <class Epi, class Map>
__device__ __forceinline__ void gemm_phase(const u16* __restrict__ A, int lda, const u16* __restrict__ Bt, int ldb,
                                           int M, int N, int K, int ntiles, Map tmap, Epi& epi, u16* smem) {
  u16* As = smem;
  u16* Bs = smem + 128 * GLD;
  const int tid = threadIdx.x, lane = tid & 63, wave = tid >> 6;
  const int wm = wave >> 1, wn = wave & 1;
  const int r = lane & 31, hh = lane >> 5;
  int t = blockIdx.x;
  if (t >= ntiles) return;
  size_t aoff[4], boff[4];
  int soff[4];
#pragma unroll
  for (int i = 0; i < 4; ++i) { int c = tid + 256 * i; soff[i] = (c >> 3) * GLD + (c & 7) * 8; }
  auto set_tile = [&](int m0, int n0) {
#pragma unroll
    for (int i = 0; i < 4; ++i) {
      int c = tid + 256 * i;
      int row = c >> 3, kc = c & 7;
      int ar = m0 + row; ar = ar < M ? ar : M - 1;
      int br = n0 + row; br = br < N ? br : N - 1;
      aoff[i] = (size_t)ar * lda + kc * 8;
      boff[i] = (size_t)br * ldb + kc * 8;
    }
  };
  struct GRegs { u32x4 a[4], b[4]; };
  auto prefetch = [&](GRegs& R, int kt) {
#pragma unroll
    for (int i = 0; i < 4; ++i) {
      R.a[i] = *(const u32x4*)(A + aoff[i] + (size_t)kt * 64);
      R.b[i] = *(const u32x4*)(Bt + boff[i] + (size_t)kt * 64);
    }
  };
  auto lds_write = [&](const GRegs& R, int buf) {
#pragma unroll
    for (int i = 0; i < 4; ++i) {
      *(u32x4*)(As + buf * GBUF + soff[i]) = R.a[i];
      *(u32x4*)(Bs + buf * GBUF + soff[i]) = R.b[i];
    }
  };
  const int nk = K >> 6;
  GRegs RA, RB;
  int m0, n0;
  tmap(t, m0, n0);
  set_tile(m0, n0);
  prefetch(RA, 0);
  prefetch(RB, 1);
  for (;;) {
    f32x16 acc[2][2];
#pragma unroll
    for (int i = 0; i < 2; ++i)
#pragma unroll
      for (int j = 0; j < 2; ++j)
#pragma unroll
        for (int e = 0; e < 16; ++e) acc[i][j][e] = 0.f;
    auto compute = [&](int buf) {
      const u16* Ab = As + buf * GBUF;
      const u16* Bb = Bs + buf * GBUF;
#pragma unroll
      for (int ks = 0; ks < 4; ++ks) {
        bf16x8 af[2], bfr[2];
#pragma unroll
        for (int i = 0; i < 2; ++i) {
          af[i] = *(const bf16x8*)(Ab + (wm * 64 + i * 32 + r) * GLD + ks * 16 + hh * 8);
          bfr[i] = *(const bf16x8*)(Bb + (wn * 64 + i * 32 + r) * GLD + ks * 16 + hh * 8);
        }
#pragma unroll
        for (int i = 0; i < 2; ++i)
#pragma unroll
          for (int j = 0; j < 2; ++j) acc[i][j] = MFMA32(af[i], bfr[j], acc[i][j]);
      }
    };
    lds_write(RA, 0);
    __syncthreads();
    for (int kt = 0; kt < nk; kt += 2) {
      if (kt + 2 < nk) prefetch(RA, kt + 2);
      compute(0);
      lds_write(RB, 1);
      __syncthreads();
      if (kt + 3 < nk) prefetch(RB, kt + 3);
      compute(1);
      if (kt + 2 < nk) lds_write(RA, 0);
      __syncthreads();
    }
    const int tn = t + (int)gridDim.x;
    const bool more = tn < ntiles;
    const int cm0 = m0, cn0 = n0;
    if (more) {
      tmap(tn, m0, n0);
      set_tile(m0, n0);
      prefetch(RA, 0);
    }
#pragma unroll
    for (int i = 0; i < 2; ++i)
#pragma unroll
      for (int j = 0; j < 2; ++j) {
        const int col = cn0 + wn * 64 + j * 32 + r;
#pragma unroll
        for (int e = 0; e < 16; ++e) {
          const int row = cm0 + wm * 64 + i * 32 + (e & 3) + 8 * (e >> 2) + 4 * hh;
          epi(row, col, acc[i][j][e], (row < M) && (col < N));
        }
      }
    if (!more) break;
    prefetch(RB, 1);
    t = tn;
  }
}

struct EpiInproj {
  u16* prkv; u16* prest; float* out;
  DI void operator()(int row, int col, float v, bool valid) const {
    if (!valid) return;
    if (col < NRKV) prkv[(size_t)row * NRKV + col] = f2bf(v);
    else prest[(size_t)row * NREST + (col - NRKV)] = f2bf(v);
    if (col < CR) {
      if (row < TP) {
        if (row == LP - 1) out[O_SHIFTP + col] = v;
        else if (row == 2 * LP - 1) out[O_SHIFTP + CR + col] = v;
      } else {
        int s = row - TP;
        if ((s & 15) == 15) out[O_SHIFTS + (size_t)(s >> 4) * CR + col] = v;
      }
    }
  }
};
struct EpiDecay {
  float* wd; const float* base;
  DI void operator()(int row, int col, float v, bool valid) const {
    if (valid) wd[(size_t)row * 512 + col] = __expf(-DECAY_SCALE * sigmoidf_(base[col] + v));
  }
};
struct EpiAaa {
  u16* aa; const float* base;
  DI void operator()(int row, int col, float v, bool valid) const {
    if (valid) aa[(size_t)row * 512 + col] = f2bf(sigmoidf_(base[col] + v));
  }
};
struct EpiStoreBf {
  u16* dst; int ld;
  DI void operator()(int row, int col, float v, bool valid) const {
    if (valid) dst[(size_t)row * ld + col] = f2bf(v);
  }
};
struct EpiQ {
  u16* q; const float* cosT; const float* sinT;
  DI void operator()(int row, int col, float v, bool valid) const {
    int dcol = col % 96;
    float partner = __shfl_xor(v, 16);
    if (dcol >= 64) {
      int rr = row < MT ? row : MT - 1;
      int pos = rr < TP ? (rr % LP) : 2048 + ((rr - TP) & 15);
      int i = (dcol - 64) & 15;
      float c = cosT[pos * 16 + i], s = sinT[pos * 16 + i];
      v = (dcol < 80) ? (v * c - partner * s) : (partner * s + v * c);
    }
    if (valid) q[(size_t)row * 768 + col] = f2bf(v * QSCALE);
  }
};
struct EpiOut {
  const float* x; const float* xs; const float* stats; const float* g; const float* b; float* out;
  DI void operator()(int row, int col, float v, bool valid) const {
    if (!valid) return;
    int m = row < 16384 ? ((row >> 13) * LP + 16 + (row & 8191)) : (TP + row - 16384);
    float mu = stats[2 * m], rs = stats[2 * m + 1];
    const float xv = row < 16384 ? x[(size_t)row * 1024 + col] : xs[(size_t)(row - 16384) * 1024 + col];
    float h = (xv - mu) * rs * g[col] + b[col];
    out[(size_t)row * 1024 + col] = ALPHA * h + v;
  }
};
struct EpiUp {
  u16* act;
  DI void operator()(int row, int col, float v, bool valid) const {
    if (valid) { float t = v > 0.f ? v : 0.f; act[(size_t)row * 4096 + col] = f2bf(t * t); }
  }
};
struct EpiDown {
  float* out;
  DI void operator()(int row, int col, float v, bool valid) const {
    if (valid) { size_t o = (size_t)row * 1024 + col; out[o] = out[o] + v; }
  }
};
struct EpiDownAtomic {
  float* out;
  DI void operator()(int row, int col, float v, bool valid) const {
    if (valid) atomicAdd(out + (size_t)row * 1024 + col, v);
  }
};

__device__ __forceinline__ void transpose_tiles(const float* __restrict__ src, int ld_src, u16* __restrict__ dst, int K, int Nd, int mode,
                                float* tl) {
  const int tid = threadIdx.x, tx = tid & 31, ty = tid >> 5;
  const int ntn = Nd >> 5, ntk = K >> 5;
  for (int t = blockIdx.x; t < ntn * ntk; t += gridDim.x) {
    int tn = t % ntn, tk = t / ntn;
    int n0 = tn * 32, k0 = tk * 32;
    int n = n0 + tx;
    int sc = mode == 0 ? n : ((n >> 6) * 128 + (n & 63) + (mode == 2 ? 64 : 0));
#pragma unroll
    for (int i = 0; i < 4; ++i) {
      int k = k0 + ty + 8 * i;
      tl[(ty + 8 * i) * 33 + tx] = src[(size_t)k * ld_src + sc];
    }
    __syncthreads();
#pragma unroll
    for (int i = 0; i < 4; ++i) {
      int nn = ty + 8 * i;
      dst[(size_t)(n0 + nn) * K + k0 + tx] = f2bf(tl[tx * 33 + nn]);
    }
    __syncthreads();
  }
}

__device__ __forceinline__ void phase_prep(const Params& p, char* smem) {
  char* ws = p.ws;
  float* tl = (float*)smem;
  transpose_tiles(p.in[9], CIN, (u16*)(ws + OFF_WIN), 1024, CIN, 0, tl);
  transpose_tiles(p.in[22], 768, (u16*)(ws + OFF_WQB), 384, 768, 0, tl);
  transpose_tiles(p.in[24], 1024, (u16*)(ws + OFF_WKN), 256, 512, 1, tl);
  transpose_tiles(p.in[24], 1024, (u16*)(ws + OFF_WV), 256, 512, 2, tl);
  transpose_tiles(p.in[11], 512, (u16*)(ws + OFF_WDEC), 64, 512, 0, tl);
  transpose_tiles(p.in[13], 512, (u16*)(ws + OFF_WAAA), 64, 512, 0, tl);
  transpose_tiles(p.in[15], 512, (u16*)(ws + OFF_WGATE), 128, 512, 0, tl);
  transpose_tiles(p.in[26], 1024, (u16*)(ws + OFF_WOUT), 1024, 1024, 0, tl);
  transpose_tiles(p.in[29], 4096, (u16*)(ws + OFF_WUP), 1024, 4096, 0, tl);
  transpose_tiles(p.in[30], 1024, (u16*)(ws + OFF_WDOWN), 4096, 1024, 0, tl);

  const int tid = threadIdx.x, lane = tid & 63, wave = tid >> 6;
  {
    u16* Hb = (u16*)(ws + OFF_R2);
    float* stats = (float*)(ws + OFF_STATS);
    const float* g = p.in[7]; const float* bb = p.in[8];
    auto rowsrc = [&](int m) -> const float* {
      if (m < TP) { int b = m / LP, l = m % LP; return l < 16 ? p.in[6] + (size_t)l * 1024 : p.in[0] + ((size_t)b * 8192 + (l - 16)) * 1024; }
      return p.in[1] + (size_t)(m - TP) * 1024;
    };
    const int stride = gridDim.x * 4;
    int m = blockIdx.x * 4 + wave;
    float4 v[4], vn[4];
    if (m < MT) {
      const float* src = rowsrc(m);
#pragma unroll
      for (int i = 0; i < 4; ++i) v[i] = *(const float4*)(src + lane * 4 + 256 * i);
    }
    for (; m < MT; m += stride) {
      const int mn = m + stride;
      {
        const float* srcn = rowsrc(mn < MT ? mn : m);
#pragma unroll
        for (int i = 0; i < 4; ++i) vn[i] = *(const float4*)(srcn + lane * 4 + 256 * i);
      }
      float s = 0.f;
#pragma unroll
      for (int i = 0; i < 4; ++i) s += v[i].x + v[i].y + v[i].z + v[i].w;
      float mu = wave_sum(s) * (1.0f / 1024.0f);
      float q = 0.f;
#pragma unroll
      for (int i = 0; i < 4; ++i) { float a = v[i].x - mu, b2 = v[i].y - mu, c = v[i].z - mu, d = v[i].w - mu; q += a * a + b2 * b2 + c * c + d * d; }
      float rs = rsqrtf(wave_sum(q) * (1.0f / 1024.0f) + 1e-5f);
      if (lane == 0) { stats[2 * m] = mu; stats[2 * m + 1] = rs; }
#pragma unroll
      for (int i = 0; i < 4; ++i) {
        int c = lane * 4 + 256 * i;
        float4 gg = *(const float4*)(g + c), b4 = *(const float4*)(bb + c);
        uint2 o;
        o.x = pack2((v[i].x - mu) * rs * gg.x + b4.x, (v[i].y - mu) * rs * gg.y + b4.y);
        o.y = pack2((v[i].z - mu) * rs * gg.z + b4.z, (v[i].w - mu) * rs * gg.w + b4.w);
        *(uint2*)(Hb + (size_t)m * 1024 + c) = o;
      }
#pragma unroll
      for (int i = 0; i < 4; ++i) v[i] = vn[i];
    }
  }
  const size_t gtid = (size_t)blockIdx.x * 256 + tid, gsz = (size_t)gridDim.x * 256;
  {
    float* cosT = (float*)(ws + OFF_ROPE); float* sinT = cosT + LP * 16;
    for (size_t e = gtid; e < (size_t)LP * 16; e += gsz) {
      int pos = (int)(e >> 4), i = (int)(e & 15);
      double inv = exp(-(double)(2 * i) / 32.0 * 9.210340371976184);
      double rev = (double)pos * inv * 0.15915494309189535;
      rev -= rint(rev);
      float rf = (float)rev;
      cosT[e] = __builtin_amdgcn_cosf(rf);
      sinT[e] = __builtin_amdgcn_sinf(rf);
    }
  }
  {
    u16* CbS = (u16*)((char*)p.out + SC_CBS);
    const float* cl = p.in[2];
    for (size_t e0 = gtid; e0 < (size_t)16 * 2048 * 64; e0 += 4 * gsz) {
      float4 v[4]; size_t ee[4];
#pragma unroll
      for (int u = 0; u < 4; ++u) {
        ee[u] = e0 + u * gsz; if (ee[u] >= (size_t)16 * 2048 * 64) ee[u] = e0;
        v[u] = *(const float4*)(cl + (ee[u] >> 6) * 256 + (ee[u] & 63) * 4);
      }
#pragma unroll
      for (int u = 0; u < 4; ++u) {
        size_t row = ee[u] >> 6; int c4 = (int)(ee[u] & 63);
        int b = (int)(row >> 11), key = (int)(row & 2047);
        uint2 o; o.x = pack2(v[u].x, v[u].y); o.y = pack2(v[u].z, v[u].w);
        *(uint2*)(CbS + ((size_t)b * LKS + key) * 256 + c4 * 4) = o;
      }
    }
    u16* KRs = (u16*)(ws + OFF_KRS);
    const float* cr = p.in[3];
    for (size_t e = gtid; e < (size_t)16 * 2048 * 8; e += gsz) {
      size_t row = e >> 3; int c4 = (int)(e & 7);
      int b = (int)(row >> 11), key = (int)(row & 2047);
      float4 v = *(const float4*)(cr + row * 32 + c4 * 4);
      uint2 o; o.x = pack2(v.x, v.y); o.y = pack2(v.z, v.w);
      *(uint2*)(KRs + ((size_t)b * LKS + key) * 32 + c4 * 4) = o;
    }
  }
}

__device__ __forceinline__ void phase_postproj(const Params& p) {
  char* ws = p.ws;
  const int lane = threadIdx.x & 63, wave = threadIdx.x >> 6;
  const u16* Prest = (const u16*)(ws + OFF_R6);
  u16* Lin = (u16*)((char*)p.out + SC_LIN);
  u16* Qn = (u16*)((char*)p.out + SC_QN);
  u16* CbP = (u16*)((char*)p.out + SC_CBP);
  u16* CbS = (u16*)((char*)p.out + SC_CBS);
  u16* KRp = (u16*)(ws + OFF_KRP);
  u16* KRs = (u16*)(ws + OFF_KRS);
  const float* cosT = (const float*)(ws + OFF_ROPE); const float* sinT = cosT + LP * 16;
  const float* mu_shift = p.in[10];
  const float* sshift = p.in[5];
  const float* qg = p.in[21]; const float* kvg = p.in[23];
  for (int m = blockIdx.x * 4 + wave; m < MT; m += gridDim.x * 4) {
    const bool prompt = m < TP;
    int b, l;
    if (prompt) { b = m / LP; l = m % LP; } else { b = (m - TP) >> 4; l = (m - TP) & 15; }
    const u16* row = Prest + (size_t)m * NREST;
#pragma unroll
    for (int i = 0; i < 4; ++i) {
      int c = lane + 64 * i;
      float cur = bf2f(row[c]);
      float prev;
      if (l > 0) prev = bf2f(row[c - NREST]);
      else prev = prompt ? 0.f : sshift[(size_t)b * CR + NRKV + c];
      float x = cur + mu_shift[NRKV + c] * (prev - cur);
      float o = i == 0 ? tanhf_(x) : (i == 1 ? x : sigmoidf_(x));
      Lin[(size_t)m * 256 + c] = f2bf(o);
    }
    {
      float v[6]; float ss = 0.f;
#pragma unroll
      for (int i = 0; i < 6; ++i) { v[i] = bf2f(row[256 + lane + 64 * i]); ss += v[i] * v[i]; }
      float rs = rsqrtf(wave_sum(ss) * (1.0f / 384.0f) + 1e-6f);
#pragma unroll
      for (int i = 0; i < 6; ++i) Qn[(size_t)m * 384 + lane + 64 * i] = f2bf(v[i] * rs * qg[lane + 64 * i]);
    }
    {
      float v[4]; float ss = 0.f;
#pragma unroll
      for (int i = 0; i < 4; ++i) { v[i] = bf2f(row[640 + lane + 64 * i]); ss += v[i] * v[i]; }
      float rs = rsqrtf(wave_sum(ss) * (1.0f / 256.0f) + 1e-6f);
      float* lo = prompt ? p.out + O_LATP + (size_t)m * 256 : p.out + O_LATS + (size_t)(m - TP) * 256;
      u16* cb = prompt ? CbP + (size_t)m * 256 : CbS + ((size_t)b * LKS + 2048 + l) * 256;
#pragma unroll
      for (int i = 0; i < 4; ++i) {
        float c = v[i] * rs * kvg[lane + 64 * i];
        lo[lane + 64 * i] = c;
        cb[lane + 64 * i] = f2bf(c);
      }
    }
    {
      int i = lane & 15;
      float x1 = bf2f(row[896 + i]), x2 = bf2f(row[912 + i]);
      int pos = prompt ? l : 2048 + l;
      float c = cosT[pos * 16 + i], s = sinT[pos * 16 + i];
      float o1 = x1 * c - x2 * s, o2 = x1 * s + x2 * c;
      float* ro = prompt ? p.out + O_ROPEP + (size_t)m * 32 : p.out + O_ROPES + (size_t)(m - TP) * 32;
      u16* kr = prompt ? KRp + (size_t)m * 32 : KRs + ((size_t)b * LKS + 2048 + l) * 32;
      if (lane < 16) { ro[i] = o1; ro[16 + i] = o2; kr[i] = f2bf(o1); kr[16 + i] = f2bf(o2); }
    }
  }
}

struct ShiftSave { unsigned d[12]; };
__device__ __forceinline__ void shift_save(const Params& p, ShiftSave& sv) {
  const int lane = threadIdx.x & 63, wave = threadIdx.x >> 6;
  const int tpw = (MT + (int)gridDim.x * 4 - 1) / ((int)gridDim.x * 4);
  const int m_lo = (blockIdx.x * 4 + wave) * tpw;
  const unsigned* Pd = (const unsigned*)(p.ws + OFF_PRKV);
  const int mr = (m_lo > 0 && m_lo < MT) ? m_lo - 1 : 0;
#pragma unroll
  for (int i = 0; i < 12; ++i) sv.d[i] = Pd[(size_t)mr * (NRKV / 2) + lane + 64 * i];
}
__device__ __forceinline__ void shift_apply(const Params& p, const ShiftSave& sv) {
  const int lane = threadIdx.x & 63, wave = threadIdx.x >> 6;
  const int tpw = (MT + (int)gridDim.x * 4 - 1) / ((int)gridDim.x * 4);
  const int m_lo = (blockIdx.x * 4 + wave) * tpw;
  if (m_lo >= MT) return;
  const int m_hi = (m_lo + tpw < MT) ? m_lo + tpw : MT;
  unsigned* Pd = (unsigned*)(p.ws + OFF_PRKV);
  float* PRE8 = (float*)(p.ws + OFF_PRE8);
  const float* mu = p.in[10];
  const float* k_k = p.in[16];
  for (int m = m_hi - 1; m >= m_lo; --m) {
    const bool prompt = m < TP;
    int b, l;
    if (prompt) { b = m / LP; l = m % LP; } else { b = (m - TP) >> 4; l = (m - TP) & 15; }
    unsigned* row = Pd + (size_t)m * (NRKV / 2);
    unsigned cur[12], prv[12];
#pragma unroll
    for (int i = 0; i < 12; ++i) cur[i] = row[lane + 64 * i];
    if (l > 0 && m > m_lo) {
#pragma unroll
      for (int i = 0; i < 12; ++i) prv[i] = row[lane + 64 * i - NRKV / 2];
    } else {
#pragma unroll
      for (int i = 0; i < 12; ++i) prv[i] = sv.d[i];
    }
#pragma unroll
    for (int i = 0; i < 12; ++i) {
      const int c = 2 * (lane + 64 * i);
      float c0 = __uint_as_float(cur[i] << 16), c1 = __uint_as_float(cur[i] & 0xFFFF0000u);
      float p0 = __uint_as_float(prv[i] << 16), p1 = __uint_as_float(prv[i] & 0xFFFF0000u);
      if (l == 0) {
        if (prompt) { p0 = 0.f; p1 = 0.f; }
        else { const float2 q = *(const float2*)(p.in[5] + (size_t)b * CR + c); p0 = q.x; p1 = q.y; }
      }
      const float2 mm = *(const float2*)(mu + c);
      const float o0 = c0 + mm.x * (p0 - c0), o1 = c1 + mm.y * (p1 - c1);
      row[lane + 64 * i] = pack2(o0, o1);
      if (i >= 4 && i < 8) {
        const float2 kw = *(const float2*)(k_k + c - 512);
        const float q0 = o0 * kw.x, q1 = o1 * kw.y;
        const float ss = allreduce32(fmaf(q0, q0, q1 * q1));
        if ((lane & 31) == 0) PRE8[(size_t)m * 8 + 2 * (i - 4) + (lane >> 5)] = __builtin_amdgcn_rsqf(fmaxf(ss, 1e-24f));
      }
    }
  }
}

__device__ __forceinline__ void phase_gemms3(const Params& p, u16* smem) {
  char* ws = p.ws;
  const u16* Lin = (const u16*)((char*)p.out + SC_LIN);
  const u16* Qn = (const u16*)((char*)p.out + SC_QN);
  const u16* CbP = (const u16*)((char*)p.out + SC_CBP);
  const u16* CbS = (const u16*)((char*)p.out + SC_CBS);
  constexpr int TM = (MT + 127) / 128;
  constexpr int TMP = (TP + 127) / 128;
  constexpr int TMS = TKS / 128;
  constexpr int J0 = TM * 4, J1 = J0 + TM * 4, J2 = J1 + TM * 4, J3 = J2 + TM * 6, J4 = J3 + TMP * 4, J5 = J4 + TMP * 4,
                J6 = J5 + TMS * 4, J7 = J6 + TMS * 4;
  for (int t = blockIdx.x; t < J7; t += gridDim.x) {
    if (t < J0) {
      EpiDecay e{(float*)(ws + OFF_R2), p.in[12]};
      gemm_tile(Lin, 256, (const u16*)(ws + OFF_WDEC), 64, MT, 512, 64, (t >> 2) * 128, (t & 3) * 128, e, smem);
    } else if (t < J1) {
      int u = t - J0;
      EpiAaa e{(u16*)((char*)p.out + SC_AA), p.in[14]};
      gemm_tile(Lin + 64, 256, (const u16*)(ws + OFF_WAAA), 64, MT, 512, 64, (u >> 2) * 128, (u & 3) * 128, e, smem);
    } else if (t < J2) {
      int u = t - J1;
      EpiStoreBf e{(u16*)(ws + OFF_GG), 512};
      gemm_tile(Lin + 128, 256, (const u16*)(ws + OFF_WGATE), 128, MT, 512, 128, (u >> 2) * 128, (u & 3) * 128, e, smem);
    } else if (t < J3) {
      int u = t - J2;
      EpiQ e{(u16*)(ws + OFF_Q), (const float*)(ws + OFF_ROPE), (const float*)(ws + OFF_ROPE) + LP * 16};
      gemm_tile(Qn, 384, (const u16*)(ws + OFF_WQB), 384, MT, 768, 384, (u / 6) * 128, (u % 6) * 128, e, smem);
    } else if (t < J4) {
      int u = t - J3;
      EpiStoreBf e{(u16*)(ws + OFF_KNP), 512};
      gemm_tile(CbP, 256, (const u16*)(ws + OFF_WKN), 256, TP, 512, 256, (u >> 2) * 128, (u & 3) * 128, e, smem);
    } else if (t < J5) {
      int u = t - J4;
      EpiStoreBf e{(u16*)(ws + OFF_VTP), LDVP};
      gemm_tile((const u16*)(ws + OFF_WV), 256, CbP, 256, 512, TP, 256, (u & 3) * 128, (u >> 2) * 128, e, smem);
    } else if (t < J6) {
      int u = t - J5;
      EpiStoreBf e{(u16*)(ws + OFF_R6), 512};
      gemm_tile(CbS, 256, (const u16*)(ws + OFF_WKN), 256, TKS, 512, 256, (u >> 2) * 128, (u & 3) * 128, e, smem);
    } else {
      int u = t - J6;
      EpiStoreBf e{(u16*)(ws + OFF_VTS), LDVS};
      gemm_tile((const u16*)(ws + OFF_WV), 256, CbS, 256, 512, TKS, 256, (u & 3) * 128, (u >> 2) * 128, e, smem);
    }
  }
}

constexpr int SB_A4 = 0, SB_B4 = 2816, SB_VV = 5632, SB_SIZE = 5712;
constexpr int SB_YP = 2 * SB_SIZE, SB_YPSZ = 64 * 36;
DI float afma(float a, float b, float c) { float r; asm("v_fma_f32 %0, %1, %2, %3" : "=v"(r) : "v"(a), "v"(b), "v"(c)); return r; }
DI float amul(float a, float b) { float r; asm("v_mul_f32 %0, %1, %2" : "=v"(r) : "v"(a), "v"(b)); return r; }
DI void lds_barrier() { asm volatile("s_waitcnt lgkmcnt(0)\n\ts_barrier" ::: "memory"); }
DI float bflo(unsigned u) { return __uint_as_float(u << 16); }
DI float bfhi(unsigned u) { return __uint_as_float(u & 0xFFFF0000u); }
struct ScanRaw { unsigned rs[4], ks[4], av[4]; float2 wv[4]; float inv[4]; float vs; };
__device__ __forceinline__ void scan_item(const Params& p, bool prompt, int b, int h, int grp, float* smem) {
  char* ws = p.ws;
  const int tid = threadIdx.x, lane = tid & 63, wave = tid >> 6;
  const u16* Prkv = (const u16*)(ws + OFF_PRKV);
  const float* Wd = (const float*)(ws + OFF_R2);
  const u16* Aa = (const u16*)((const char*)p.out + SC_AA);
  u16* Yb = (u16*)((char*)p.out + SC_YB);
  const int L = prompt ? LP : 16;
  const int nchunks = L / 16;
  const size_t mbase = prompt ? (size_t)b * LP : (size_t)TP + b * 16;
  const int c2 = lane & 31, ts = lane >> 5;

  if (wave < 2) {
    const int row4 = wave * 2 + ts;
    const int irow = grp * 4 + row4;
    const size_t sidx = (((size_t)b * 8 + h) * 64 + irow) * 64 + c2 * 2;
    float s0 = 0.f, s1 = 0.f;
    if (!prompt) { float2 t = *(const float2*)(p.in[4] + sidx); s0 = t.x; s1 = t.y; }
    lds_barrier();
    for (int c = 0; c < nchunks; ++c) {
      const float* pa = smem + (c & 1) * SB_SIZE + SB_A4 + c2 * 4;
      const float* pb = smem + (c & 1) * SB_SIZE + SB_B4 + c2 * 4;
      const float* pv = smem + (c & 1) * SB_SIZE + SB_VV + row4 * 20;
      float* py = smem + SB_YP + (c & 1) * SB_YPSZ + row4 * 36 + c2;
      float4 Aq[6], Bq[6];
      float4 Vc = *(const float4*)(pv), Vn = *(const float4*)(pv + 4);
#pragma unroll
      for (int i = 0; i < 6; ++i) {
        Aq[i] = *(const float4*)(pa + i * 128); Bq[i] = *(const float4*)(pb + i * 128);
      }
#pragma unroll
      for (int t = 0; t < 16; ++t) {
        const int sl = t % 6, vl = t & 3;
        if (vl == 0 && t > 0) { Vc = Vn; Vn = *(const float4*)(pv + t + 4); }
        const float4 A0 = Aq[sl], B0 = Bq[sl];
        const float v0 = vl == 0 ? Vc.x : (vl == 1 ? Vc.y : (vl == 2 ? Vc.z : Vc.w));
        Aq[sl] = *(const float4*)(pa + (t + 6) * 128); Bq[sl] = *(const float4*)(pb + (t + 6) * 128);
        const float a0 = bflo(__float_as_uint(A0.z)), a1 = bfhi(__float_as_uint(A0.z));
        const float2 R0 = make_float2(bflo(__float_as_uint(A0.w)), bfhi(__float_as_uint(A0.w)));
        float sa = amul(s0, a0) + amul(s1, a1);
        const float d0 = afma(v0, B0.z, amul(s0, A0.x)), d1 = afma(v0, B0.w, amul(s1, A0.y));
        sa = allreduce32(sa);
        s0 = afma(sa, B0.x, d0); s1 = afma(sa, B0.y, d1);
        py[t * 144] = amul(s0, R0.x) + amul(s1, R0.y);
      }
      lds_barrier();
    }
    float* so = p.out + (prompt ? O_STATEP : O_STATES) + sidx;
    *(float2*)so = make_float2(s0, s1);
  } else {
    const int ubeg = wave == 2 ? 0 : 4;
    const int hc = h * 64 + 2 * c2;
    const float2 kkw = *(const float2*)(p.in[16] + hc), kaw = *(const float2*)(p.in[17] + hc);
    const int vr4 = lane & 3, vtt = lane >> 2;
    const int vcol = h * 64 + grp * 4 + vr4;
    const float* PRE8 = (const float*)(ws + OFF_PRE8);
    auto prefetch = [&](ScanRaw& R, int chunk) {
      chunk = chunk < nchunks ? chunk : nchunks - 1;
      const int t0 = chunk * 16;
#pragma unroll
      for (int i = 0; i < 4; ++i) {
        const size_t m = mbase + t0 + 2 * (ubeg + i) + ts;
        const u16* row = Prkv + m * NRKV;
        R.rs[i] = *(const unsigned*)(row + hc); R.ks[i] = *(const unsigned*)(row + 512 + hc);
        R.wv[i] = *(const float2*)(Wd + m * 512 + hc);
        R.av[i] = *(const unsigned*)(Aa + m * 512 + hc);
        R.inv[i] = PRE8[m * 8 + h];
      }
      R.vs = bf2f(Prkv[(mbase + t0 + vtt) * NRKV + 1024 + vcol]);
    };
    auto stage = [&](const ScanRaw& R, float* buf) {
#pragma unroll
      for (int i = 0; i < 4; ++i) {
        const int tt = 2 * (ubeg + i) + ts;
        const float r0 = bflo(R.rs[i]), r1 = bfhi(R.rs[i]);
        const float k0 = bflo(R.ks[i]), k1 = bfhi(R.ks[i]);
        const float a0 = bflo(R.av[i]), a1 = bfhi(R.av[i]);
        const float kk0 = k0 * kkw.x * R.inv[i], kk1 = k1 * kkw.y * R.inv[i];
        const float kt0 = k0 * (1.0f + (a0 - 1.0f) * kaw.x), kt1 = k1 * (1.0f + (a1 - 1.0f) * kaw.y);
        *(float4*)(buf + SB_A4 + (tt * 32 + c2) * 4) = make_float4(R.wv[i].x, R.wv[i].y, __uint_as_float(pack2(-kk0, -kk1)), __uint_as_float(R.rs[i]));
        *(float4*)(buf + SB_B4 + (tt * 32 + c2) * 4) = make_float4(kk0 * a0, kk1 * a1, kt0, kt1);
      }
      if (wave == 3) buf[SB_VV + vr4 * 20 + vtt] = R.vs;
    };
    auto yflush = [&](int chunk) {
      chunk = chunk < 0 ? 0 : chunk;
      const float4* yp = (const float4*)(smem + SB_YP + (chunk & 1) * SB_YPSZ + lane * 36);
      float4 acc = yp[0];
#pragma unroll
      for (int i = 1; i < 8; ++i) { const float4 q = yp[i]; acc.x += q.x; acc.y += q.y; acc.z += q.z; acc.w += q.w; }
      const float y = (acc.x + acc.y) + (acc.z + acc.w);
      Yb[(mbase + chunk * 16 + vtt) * 512 + vcol] = f2bf(y);
    };
    ScanRaw S0, S1;
    prefetch(S0, 0);
    prefetch(S1, 1);
    stage(S0, smem);
    prefetch(S0, 2);
    lds_barrier();
    int c = 0;
    for (; c + 1 < nchunks; c += 2) {
      stage(S1, smem + SB_SIZE);
      prefetch(S1, c + 3);
      if (wave == 2) yflush(c - 1);
      lds_barrier();
      stage(S0, smem);
      prefetch(S0, c + 4);
      if (wave == 2) yflush(c);
      lds_barrier();
    }
    if (wave == 2) yflush(c - 1);
    lds_barrier();
    if (wave == 2) yflush(nchunks - 1);
  }
  __syncthreads();
}

constexpr int KLD = 104;
constexpr int VLD = 68;
constexpr int ATT_BUF = 64 * KLD + 64 * VLD;
__device__ __forceinline__ void attn_item(const u16* __restrict__ Q, int qrow_lim, const u16* __restrict__ Kn, const u16* __restrict__ KR,
                          const u16* __restrict__ Vt, int ldv, int first_valid, int nk_lo, int nk_hi, u16* __restrict__ O,
                          int q_valid, u16* smem) {
  u16* Ks = smem;
  u16* Vs = smem + 64 * KLD;
  const int tid = threadIdx.x, lane = tid & 63, wave = tid >> 6;
  const int r = lane & 31, hh = lane >> 5;
  const int my_nk = wave < 2 ? nk_lo : nk_hi;
  auto ntiles = [&](int nk) { return nk <= first_valid ? 1 : 1 + (nk - first_valid + 63) / 64; };
  const int nt_all = ntiles(nk_hi);
  const int my_nt = (wave * 32 < q_valid) ? ntiles(my_nk) : 0;
  bf16x8 qf[6];
  {
    int qr = wave * 32 + r; qr = qr < qrow_lim ? qr : qrow_lim - 1;
    const u16* qp = Q + (size_t)qr * 768 + hh * 8;
#pragma unroll
    for (int ks = 0; ks < 6; ++ks) qf[ks] = *(const bf16x8*)(qp + ks * 16);
  }
  int kkey[3], kch[3];
#pragma unroll
  for (int i = 0; i < 3; ++i) { int id = tid + 256 * i; kkey[i] = id / 12; kch[i] = id % 12; }
  struct KVRegs { u32x4 rk[3]; u32x4 rv[2]; };
  auto prefetch = [&](KVRegs& R, int kt) {
    int start = kt == 0 ? 0 : first_valid + 64 * (kt - 1);
#pragma unroll
    for (int i = 0; i < 3; ++i) {
      size_t key = (size_t)(start + kkey[i]);
      const u16* src = kch[i] < 8 ? Kn + key * 512 + kch[i] * 8 : KR + key * 32 + (kch[i] - 8) * 8;
      R.rk[i] = *(const u32x4*)src;
    }
#pragma unroll
    for (int i = 0; i < 2; ++i) {
      int id = tid + 256 * i; int d = id >> 3, ch = id & 7;
      R.rv[i] = *(const u32x4*)(Vt + (size_t)d * ldv + start + ch * 8);
    }
  };
  auto lds_write = [&](const KVRegs& R, int buf) {
    u16* Kb = Ks + buf * ATT_BUF;
    u16* Vb = Vs + buf * ATT_BUF;
#pragma unroll
    for (int i = 0; i < 3; ++i) *(u32x4*)(Kb + kkey[i] * KLD + kch[i] * 8) = R.rk[i];
#pragma unroll
    for (int i = 0; i < 2; ++i) {
      int id = tid + 256 * i; int d = id >> 3, ch = id & 7;
      u32x2* dst = (u32x2*)(Vb + d * VLD + ch * 8);
      u32x2 t0 = {R.rv[i].x, R.rv[i].y}, t1 = {R.rv[i].z, R.rv[i].w};
      dst[0] = t0;
      dst[1] = t1;
    }
  };
  f32x16 o[2];
#pragma unroll
  for (int i = 0; i < 2; ++i)
#pragma unroll
    for (int e = 0; e < 16; ++e) o[i][e] = 0.f;
  float m_run = -1e30f, l_run = 0.f;
  auto compute = [&](int kt) {
    const u16* Kb = Ks + (kt & 1) * ATT_BUF;
    const u16* Vb = Vs + (kt & 1) * ATT_BUF;
    const int start = kt == 0 ? 0 : first_valid + 64 * (kt - 1);
    int tv = kt == 0 ? first_valid : 64;
    if (my_nk - start < tv) tv = my_nk - start;
    f32x16 s[2];
#pragma unroll
    for (int T = 0; T < 2; ++T)
#pragma unroll
      for (int e = 0; e < 16; ++e) s[T][e] = 0.f;
#pragma unroll
    for (int ks = 0; ks < 6; ++ks) {
#pragma unroll
      for (int T = 0; T < 2; ++T) {
        bf16x8 kf = *(const bf16x8*)(Kb + (T * 32 + r) * KLD + ks * 16 + hh * 8);
        s[T] = MFMA32(kf, qf[ks], s[T]);
      }
    }
    if (tv < 64) {
#pragma unroll
      for (int T = 0; T < 2; ++T)
#pragma unroll
        for (int e = 0; e < 16; ++e) {
          int kidx = T * 32 + (e & 3) + 8 * (e >> 2) + 4 * hh;
          if (kidx >= tv) s[T][e] = -1e30f;
        }
    }
    float mx = s[0][0];
#pragma unroll
    for (int T = 0; T < 2; ++T)
#pragma unroll
      for (int e = 0; e < 16; ++e) mx = fmaxf(mx, s[T][e]);
    mx = fmaxf(mx, __shfl_xor(mx, 32));
    const float m_new = fmaxf(m_run, mx);
    const float alpha = __builtin_amdgcn_exp2f(m_run - m_new);
    m_run = m_new;
    float rsum = 0.f;
#pragma unroll
    for (int T = 0; T < 2; ++T)
#pragma unroll
      for (int e = 0; e < 16; ++e) { float pv = __builtin_amdgcn_exp2f(s[T][e] - m_new); s[T][e] = pv; rsum += pv; }
    l_run = l_run * alpha + rsum;
#pragma unroll
    for (int i = 0; i < 2; ++i)
#pragma unroll
      for (int e = 0; e < 16; ++e) o[i][e] *= alpha;
#pragma unroll
    for (int T = 0; T < 2; ++T)
#pragma unroll
      for (int ss = 0; ss < 2; ++ss) {
        uint4 pk;
        pk.x = pack2(s[T][8 * ss + 0], s[T][8 * ss + 1]);
        pk.y = pack2(s[T][8 * ss + 2], s[T][8 * ss + 3]);
        pk.z = pack2(s[T][8 * ss + 4], s[T][8 * ss + 5]);
        pk.w = pack2(s[T][8 * ss + 6], s[T][8 * ss + 7]);
        bf16x8 pf = __builtin_bit_cast(bf16x8, pk);
#pragma unroll
        for (int dt = 0; dt < 2; ++dt) {
          const u16* vp = Vb + (dt * 32 + r) * VLD + 32 * T + 16 * ss + 4 * hh;
          uint2 lo = *(const uint2*)vp;
          uint2 hi = *(const uint2*)(vp + 8);
          uint4 vv = make_uint4(lo.x, lo.y, hi.x, hi.y);
          o[dt] = MFMA32(__builtin_bit_cast(bf16x8, vv), pf, o[dt]);
        }
      }
  };
  KVRegs RA, RB;
  prefetch(RA, 0);
  if (1 < nt_all) prefetch(RB, 1);
  lds_write(RA, 0);
  __syncthreads();
  for (int kt = 0; kt < nt_all; kt += 2) {
    if (kt + 2 < nt_all) prefetch(RA, kt + 2);
    if (kt < my_nt) compute(kt);
    if (kt + 1 < nt_all) lds_write(RB, 1);
    __syncthreads();
    if (kt + 1 < nt_all) {
      if (kt + 3 < nt_all) prefetch(RB, kt + 3);
      if (kt + 1 < my_nt) compute(kt + 1);
      if (kt + 2 < nt_all) lds_write(RA, 0);
      __syncthreads();
    }
  }
  if (my_nt > 0) {
    float l = l_run + __shfl_xor(l_run, 32);
    float inv = 1.0f / l;
    int qr = wave * 32 + r;
    if (qr < q_valid) {
#pragma unroll
      for (int dt = 0; dt < 2; ++dt)
#pragma unroll
        for (int g = 0; g < 4; ++g) {
          uint2 st;
          st.x = pack2(o[dt][4 * g + 0] * inv, o[dt][4 * g + 1] * inv);
          st.y = pack2(o[dt][4 * g + 2] * inv, o[dt][4 * g + 3] * inv);
          *(uint2*)(O + (size_t)qr * 512 + dt * 32 + 8 * g + 4 * hh) = st;
        }
    }
  }
  __syncthreads();
}

__device__ __forceinline__ void phase_mixers(const Params& p, char* smem) {
  char* ws = p.ws;
#ifndef SUBM
#define SUBM 3
#endif
  if (SUBM & 1) {
    for (int it = blockIdx.x; it < 2048; it += gridDim.x) scan_item(p, false, it >> 7, (it >> 4) & 7, it & 15, (float*)smem);
    for (int it = blockIdx.x; it < 256; it += gridDim.x) scan_item(p, true, it >> 7, (it >> 4) & 7, it & 15, (float*)smem);
  }
  if (SUBM & 2) {
    int* cnt = (int*)(ws + OFF_CNT);
    int* sitem = (int*)(smem + 81472);
    const u16* Q = (const u16*)(ws + OFF_Q);
    u16* Oat = (u16*)((char*)p.out + SC_OAT);
    constexpr int NITEMS = 128 + 1024 + 16;
    for (;;) {
      if (threadIdx.x == 0) *sitem = atomicAdd(cnt, 1);
      __syncthreads();
      const int it = *sitem;
      __syncthreads();
      if (it >= NITEMS) break;
      size_t q0, k0; int h, ldv, fv, nlo, nhi, qv;
      const u16 *kn, *kr, *vt;
      if (it < 128) {
        int b = it >> 3; h = it & 7;
        q0 = (size_t)TP + b * 16; k0 = (size_t)b * LKS;
        kn = (const u16*)(ws + OFF_R6); kr = (const u16*)(ws + OFF_KRS); vt = (const u16*)(ws + OFF_VTS);
        ldv = LDVS; fv = 64; nlo = LKS; nhi = LKS; qv = 16;
      } else {
        kn = (const u16*)(ws + OFF_KNP); kr = (const u16*)(ws + OFF_KRP); vt = (const u16*)(ws + OFF_VTP);
        ldv = LDVP; fv = 16;
        if (it < 1152) {
          int j = it - 128;
          int qb = 63 - (j >> 4), b = (j >> 3) & 1; h = j & 7;
          k0 = (size_t)b * LP; q0 = k0 + 16 + 128 * qb;
          nlo = 16 + 64 * (2 * qb + 1); nhi = 16 + 64 * (2 * qb + 2); qv = 128;
        } else {
          int j = it - 1152;
          int b = j >> 3; h = j & 7;
          k0 = (size_t)b * LP; q0 = k0;
          nlo = 16; nhi = 16; qv = 16;
        }
      }
      attn_item(Q + q0 * 768 + h * 96, MT - (int)q0, kn + k0 * 512 + h * 64, kr + k0 * 32, vt + (size_t)(h * 64) * ldv + k0, ldv, fv,
                nlo, nhi, Oat + q0 * 512 + h * 64, qv, (u16*)smem);
    }
  }
}

__device__ __forceinline__ void phase_postmix(const Params& p) {
  char* ws = p.ws;
  const int lane = threadIdx.x & 63, wave = threadIdx.x >> 6;
  const u16* Prkv = (const u16*)(ws + OFF_PRKV);
  const u16* Aa = (const u16*)((const char*)p.out + SC_AA);
  const u16* Yb = (const u16*)((const char*)p.out + SC_YB);
  const u16* Oat = (const u16*)((const char*)p.out + SC_OAT);
  const u16* Gg = (const u16*)(ws + OFF_GG);
  u16* Ocat = (u16*)(ws + OFF_OCAT);
  const float* mu_shift = p.in[10];
  const float* k_a = p.in[17]; const float* r_k = p.in[18]; const float* gn_g = p.in[19]; const float* gn_b = p.in[20];
  const float* og = p.in[25];
  for (int m2 = blockIdx.x * 4 + wave; m2 < M2; m2 += gridDim.x * 4) {
    const bool prompt = m2 < 16384;
    const int m = prompt ? ((m2 >> 13) * LP + 16 + (m2 & 8191)) : (TP + m2 - 16384);
    const bool first = (!prompt) && (((m2 - 16384) & 15) == 0);
    const float* ss = p.in[5] + (size_t)(prompt ? 0 : ((m2 - 16384) >> 4)) * CR;
    const u16* row = Prkv + (size_t)m * NRKV;
#pragma unroll 4
    for (int h = 0; h < 8; ++h) {
      int col = h * 64 + lane;
      float y = bf2f(Yb[(size_t)m * 512 + col]);
      float mu = wave_sum(y) * (1.0f / 64.0f);
      float d = y - mu;
      float var = wave_sum(d * d) * (1.0f / 64.0f);
      float yn = d * rsqrtf(var + 64e-5f) * gn_g[col] + gn_b[col];
      const float r = bf2f(row[col]), k = bf2f(row[512 + col]), v = bf2f(row[1024 + col]);
      float a = bf2f(Aa[(size_t)m * 512 + col]);
      float kt = k * (1.0f + (a - 1.0f) * k_a[col]);
      float bs = wave_sum(r * kt * r_k[col]);
      float o = (yn + bs * v) * bf2f(Gg[(size_t)m * 512 + col]);
      Ocat[(size_t)m2 * 1024 + col] = f2bf(o);
    }
    float v[8]; float sq = 0.f;
#pragma unroll
    for (int i = 0; i < 8; ++i) { v[i] = bf2f(Oat[(size_t)m * 512 + lane + 64 * i]); sq += v[i] * v[i]; }
    float rs = rsqrtf(wave_sum(sq) * (1.0f / 512.0f) + 1e-6f);
#pragma unroll
    for (int i = 0; i < 8; ++i) Ocat[(size_t)m2 * 1024 + 512 + lane + 64 * i] = f2bf(v[i] * rs * og[lane + 64 * i]);
    if (!prompt) {
      const float* xs = p.in[1] + (size_t)(m2 - 16384) * 1024;
      const float* st = (const float*)(ws + OFF_STATS) + 2 * (size_t)m;
      const float xmu = st[0], xrs = st[1];
#pragma unroll
      for (int i = 0; i < 4; ++i) {
        const int c = lane * 4 + 256 * i;
        const float4 xv = *(const float4*)(xs + c), gg = *(const float4*)(p.in[7] + c), b4 = *(const float4*)(p.in[8] + c);
        float4 o;
        o.x = ALPHA * ((xv.x - xmu) * xrs * gg.x + b4.x); o.y = ALPHA * ((xv.y - xmu) * xrs * gg.y + b4.y);
        o.z = ALPHA * ((xv.z - xmu) * xrs * gg.z + b4.z); o.w = ALPHA * ((xv.w - xmu) * xrs * gg.w + b4.w);
        *(float4*)(p.out + (size_t)m2 * 1024 + c) = o;
      }
    }
  }
}

__device__ __forceinline__ void phase_ln(const Params& p, const float* g, const float* b, u16* hb, float oscale) {
  const int lane = threadIdx.x & 63, wave = threadIdx.x >> 6;
  const int stride = gridDim.x * 4;
  for (int m2 = blockIdx.x * 4 + wave; m2 < M2; m2 += 2 * stride) {
    const int mB = m2 + stride;
    const bool hasB = mB < M2;
    float* rowA = p.out + (size_t)m2 * 1024;
    float* rowB = p.out + (size_t)(hasB ? mB : m2) * 1024;
    float4 va[4], vb[4];
#pragma unroll
    for (int i = 0; i < 4; ++i) { va[i] = *(const float4*)(rowA + lane * 4 + 256 * i); vb[i] = *(const float4*)(rowB + lane * 4 + 256 * i); }
    float sa = 0.f, sb = 0.f;
#pragma unroll
    for (int i = 0; i < 4; ++i) { sa += va[i].x + va[i].y + va[i].z + va[i].w; sb += vb[i].x + vb[i].y + vb[i].z + vb[i].w; }
    const float muA = wave_sum(sa) * (1.0f / 1024.0f), muB = wave_sum(sb) * (1.0f / 1024.0f);
    float qa = 0.f, qb = 0.f;
#pragma unroll
    for (int i = 0; i < 4; ++i) {
      float a0 = va[i].x - muA, a1 = va[i].y - muA, a2 = va[i].z - muA, a3 = va[i].w - muA;
      float b0 = vb[i].x - muB, b1 = vb[i].y - muB, b2 = vb[i].z - muB, b3 = vb[i].w - muB;
      qa += a0 * a0 + a1 * a1 + a2 * a2 + a3 * a3;
      qb += b0 * b0 + b1 * b1 + b2 * b2 + b3 * b3;
    }
    const float rsA = rsqrtf(wave_sum(qa) * (1.0f / 1024.0f) + 1e-5f), rsB = rsqrtf(wave_sum(qb) * (1.0f / 1024.0f) + 1e-5f);
#pragma unroll
    for (int i = 0; i < 4; ++i) {
      int c = lane * 4 + 256 * i;
      float4 gg = *(const float4*)(g + c), b4 = *(const float4*)(b + c);
      float4 o;
      o.x = (va[i].x - muA) * rsA * gg.x + b4.x; o.y = (va[i].y - muA) * rsA * gg.y + b4.y;
      o.z = (va[i].z - muA) * rsA * gg.z + b4.z; o.w = (va[i].w - muA) * rsA * gg.w + b4.w;
      *(float4*)(rowA + c) = make_float4(o.x * oscale, o.y * oscale, o.z * oscale, o.w * oscale);
      if (hb) { uint2 t; t.x = pack2(o.x, o.y); t.y = pack2(o.z, o.w); *(uint2*)(hb + (size_t)m2 * 1024 + c) = t; }
      if (hasB) {
        o.x = (vb[i].x - muB) * rsB * gg.x + b4.x; o.y = (vb[i].y - muB) * rsB * gg.y + b4.y;
        o.z = (vb[i].z - muB) * rsB * gg.z + b4.z; o.w = (vb[i].w - muB) * rsB * gg.w + b4.w;
        *(float4*)(rowB + c) = make_float4(o.x * oscale, o.y * oscale, o.z * oscale, o.w * oscale);
        if (hb) { uint2 t; t.x = pack2(o.x, o.y); t.y = pack2(o.z, o.w); *(uint2*)(hb + (size_t)mB * 1024 + c) = t; }
      }
    }
  }
}

DI void fast_barrier(unsigned* word) {
  asm volatile("s_waitcnt vmcnt(0) lgkmcnt(0)" ::: "memory");
  __syncthreads();
  if (threadIdx.x == 0) {
    __builtin_amdgcn_fence(__ATOMIC_RELEASE, "agent");
    asm volatile("s_waitcnt vmcnt(0)" ::: "memory");
    __hip_atomic_fetch_add(word, 1u, __ATOMIC_RELAXED, __HIP_MEMORY_SCOPE_AGENT);
    const unsigned target = gridDim.x;
    unsigned spins = 0;
    while (__hip_atomic_load(word, __ATOMIC_RELAXED, __HIP_MEMORY_SCOPE_AGENT) < target) {
      __builtin_amdgcn_s_sleep(2);
      if (++spins > (1u << 24)) break;
    }
    __builtin_amdgcn_fence(__ATOMIC_ACQUIRE, "agent");
    asm volatile("s_waitcnt vmcnt(0)" ::: "memory");
  }
  __syncthreads();
}

#define XB_TMO      128
#define XB_XCNT(j)  (256  + 64 * (j))
#define XB_XSUB(j)  (1280 + 64 * (j))
#define XB_XGEN(j)  (2304 + 64 * (j))
#define XB_TOP      3328
#define XB_TOPGEN   3392
#define XB_SPIN_CAP (1u << 20)
DI unsigned xb_ld(unsigned* p) { return __hip_atomic_load(p, __ATOMIC_RELAXED, __HIP_MEMORY_SCOPE_AGENT); }
DI unsigned xb_add(unsigned* p, unsigned v) { return __hip_atomic_fetch_add(p, v, __ATOMIC_RELAXED, __HIP_MEMORY_SCOPE_AGENT); }
DI unsigned xb_xcc_id() { return (unsigned)__builtin_amdgcn_s_getreg((3 << 11) | 20) & 0xFu; }
#define XB_SPIN(cond, bar) do { unsigned _sp = 0; while (cond) { __builtin_amdgcn_s_sleep(1); \
    if ((++_sp & 255u) == 0u) { if (xb_ld(&(bar)[XB_TMO])) break; if (_sp > XB_SPIN_CAP) { atomicAdd(&(bar)[XB_TMO], 1u); break; } } } } while (0)
struct XcdBarrier { unsigned* bar; unsigned x; volatile unsigned* st; };
DI XcdBarrier xcd_barrier_post(unsigned* bar, volatile unsigned* st) {
  XcdBarrier b; b.bar = bar; b.x = xb_xcc_id(); b.st = st;
  if (threadIdx.x == 0) (void)xb_add(&bar[XB_XCNT(b.x)], 1u);
  return b;
}
DI void xcd_barrier_complete(unsigned* bar, unsigned x, unsigned& nloc, unsigned& nx) {
  const unsigned G = gridDim.x;
  unsigned sum, cnt, mine, sp = 0u;
  for (;;) {
    sum = 0u; cnt = 0u; mine = 0u;
#pragma unroll
    for (unsigned j = 0; j < 16; ++j) { const unsigned c = xb_ld(&bar[XB_XCNT(j)]); sum += c; cnt += (c > 0u) ? 1u : 0u; mine = (j == x) ? c : mine; }
    if (sum == G) break;
    __builtin_amdgcn_s_sleep(1);
    if ((++sp & 255u) == 0u) { if (xb_ld(&bar[XB_TMO])) break; if (sp > XB_SPIN_CAP) { atomicAdd(&bar[XB_TMO], 1u); break; } }
  }
  nloc = mine > 0u ? mine : 1u; nx = cnt > 0u ? cnt : 1u;
}
DI void xcd_barrier(const XcdBarrier& b) {
  asm volatile("s_waitcnt vmcnt(0)" ::: "memory");
  __syncthreads();
  if (threadIdx.x == 0) {
    unsigned* bar = b.bar;
    __builtin_amdgcn_s_waitcnt(0);
    unsigned nloc = b.st[0], nx = b.st[1];
    if (nloc == 0u) { xcd_barrier_complete(bar, b.x, nloc, nx); b.st[0] = nloc; b.st[1] = nx; }
    const unsigned old = xb_add(&bar[XB_XSUB(b.x)], 1u);
    const unsigned gen = old / nloc;
    if (old + 1u == (gen + 1u) * nloc) {
      __builtin_amdgcn_fence(__ATOMIC_RELEASE, "agent");
      asm volatile("s_waitcnt vmcnt(0)" ::: "memory");
      const unsigned og = xb_add(&bar[XB_TOP], 1u);
      const unsigned tg = og / nx;
      if (og + 1u == (tg + 1u) * nx) xb_add(&bar[XB_TOPGEN], 1u);
      else XB_SPIN(xb_ld(&bar[XB_TOPGEN]) == tg, bar);
      __builtin_amdgcn_fence(__ATOMIC_ACQUIRE, "agent");
      xb_add(&bar[XB_XGEN(b.x)], 1u);
      asm volatile("s_waitcnt vmcnt(0)" ::: "memory");
    } else {
      XB_SPIN(xb_ld(&bar[XB_XGEN(b.x)]) == gen, bar);
      __builtin_amdgcn_fence(__ATOMIC_ACQUIRE, "agent");
      asm volatile("s_waitcnt vmcnt(0)" ::: "memory");
    }
  }
  __syncthreads();
}

__global__ void __launch_bounds__(256, 2) fwd_megakernel(Params p) {
  __shared__ __attribute__((aligned(16))) char smem[SMEM_BYTES];
  cg::grid_group grid = cg::this_grid();
  char* ws = p.ws;
  unsigned* bar = (unsigned*)(ws + OFF_CNT);

#ifndef PHM
#define PHM 0xFFFF
#endif
  volatile unsigned* xst = (volatile unsigned*)(smem + 81472 + 16);
  if (threadIdx.x == 0) { xst[0] = 0u; xst[1] = 0u; }
  __syncthreads();
  const XcdBarrier xbar = xcd_barrier_post((unsigned*)(ws + OFF_XB), xst);
  if (PHM & 1) phase_prep(p, smem);
  if (p.ws == nullptr) grid.sync();
  xcd_barrier(xbar);
  if (PHM & 2) {
    EpiInproj e{(u16*)(ws + OFF_PRKV), (u16*)(ws + OFF_R6), p.out};
    constexpr int TM = (MT + 127) / 128, TN = (CIN + 127) / 128;
    gemm_phase((const u16*)(ws + OFF_R2), 1024, (const u16*)(ws + OFF_WIN), 1024, MT, CIN, 1024, TM * TN,
               [](int t, int& m0, int& n0) { m0 = (t / TN) * 128; n0 = (t % TN) * 128; }, e, (u16*)smem);
  }
  xcd_barrier(xbar);
  if (PHM & 4) phase_postproj(p);
  {
    ShiftSave sv;
    shift_save(p, sv);
    xcd_barrier(xbar);
    shift_apply(p, sv);
  }
  if (PHM & 8) phase_gemms3(p, (u16*)smem);
  xcd_barrier(xbar);
  if (PHM & 16) phase_mixers(p, smem);
  xcd_barrier(xbar);
  if (PHM & 32) phase_postmix(p);
  xcd_barrier(xbar);
  if (PHM & 64) {
    EpiOut e{p.in[0], p.in[1], (const float*)(ws + OFF_STATS), p.in[7], p.in[8], p.out};
    const int G = gridDim.x, NT = 130 * 8;
    const int full = (NT / G) * G, left = NT - full;
    int pieces = left > 0 ? G / left : 0; pieces = pieces > 16 ? 16 : pieces;
    const bool split = left > 0 && pieces >= 2 && (16 % pieces) == 0 && full >= 128 * 8;
    gemm_phase((const u16*)(ws + OFF_OCAT), 1024, (const u16*)(ws + OFF_WOUT), 1024, M2, 1024, 1024, split ? full : NT,
               [](int t, int& m0, int& n0) { m0 = (t >> 3) * 128; n0 = (t & 7) * 128; }, e, (u16*)smem);
    if (split && (int)blockIdx.x < left * pieces) {
      EpiDownAtomic ea{p.out};
      const int t = full + (int)blockIdx.x / pieces, pc = (int)blockIdx.x % pieces, klen = 1024 / pieces;
      gemm_tile((const u16*)(ws + OFF_OCAT), 1024, (const u16*)(ws + OFF_WOUT), 1024, M2, 1024, klen, (t >> 3) * 128, (t & 7) * 128, ea,
                (u16*)smem, pc * klen);
    }
  }
  xcd_barrier(xbar);
  if (PHM & 128) phase_ln(p, p.in[27], p.in[28], (u16*)(ws + OFF_H1B), ALPHA);
  xcd_barrier(xbar);
  if (PHM & 256) {
    EpiUp e{(u16*)(ws + OFF_ACT)};
    gemm_phase((const u16*)(ws + OFF_H1B), 1024, (const u16*)(ws + OFF_WUP), 1024, M2, 4096, 1024, 130 * 32,
               [](int t, int& m0, int& n0) { m0 = (t >> 5) * 128; n0 = (t & 31) * 128; }, e, (u16*)smem);
  }
  xcd_barrier(xbar);
  if (PHM & 512) {
    EpiDown e{p.out};
    const int G = gridDim.x, NT = 130 * 8;
    const int full = (NT / G) * G, left = NT - full;
    const int pieces = left > 0 ? G / left : 0;
    const bool split = left > 0 && pieces >= 2 && pieces <= 64 && (64 % pieces) == 0 && pieces * left == G;
    for (int t = blockIdx.x; t < (split ? full : NT); t += gridDim.x)
      gemm_tile((const u16*)(ws + OFF_ACT), 4096, (const u16*)(ws + OFF_WDOWN), 4096, M2, 1024, 4096, (t >> 3) * 128, (t & 7) * 128, e,
                (u16*)smem);
    if (split) {
      EpiDownAtomic ea{p.out};
      const int t = full + (int)blockIdx.x / pieces, pc = (int)blockIdx.x % pieces, klen = 4096 / pieces;
      gemm_tile((const u16*)(ws + OFF_ACT), 4096, (const u16*)(ws + OFF_WDOWN), 4096, M2, 1024, klen, (t >> 3) * 128, (t & 7) * 128, ea,
                (u16*)smem, pc * klen);
    }
  }
  xcd_barrier(xbar);
  if (PHM & 1024) phase_ln(p, p.in[31], p.in[32], nullptr, 1.0f);
}

extern "C" void kernel_launch(void* const* d_in, const int* in_sizes, int n_in, void* d_out, int out_size, void* d_ws,
                              size_t ws_size, hipStream_t stream) {
  static int grid_blocks = 0;
  if (!grid_blocks) {
    int dev = 0, cus = 0, per_cu = 0;
    hipGetDevice(&dev);
    hipDeviceGetAttribute(&cus, hipDeviceAttributeMultiprocessorCount, dev);
    hipOccupancyMaxActiveBlocksPerMultiprocessor(&per_cu, (const void*)fwd_megakernel, 256, 0);
    if (per_cu > 2) per_cu = 2;
    if (per_cu < 1) per_cu = 1;
    grid_blocks = cus * per_cu;
  }
  Params p{};
  for (int i = 0; i < 33; ++i) p.in[i] = (const float*)d_in[i];
  p.out = (float*)d_out;
  p.ws = (char*)d_ws;
  hipMemsetAsync((char*)d_ws + OFF_CNT, 0, 8192, stream);
  hipMemsetAsync((char*)d_ws + OFF_XB, 0, 16384, stream);
  void* args[] = {&p};
  hipError_t e = hipLaunchCooperativeKernel((const void*)fwd_megakernel, dim3(grid_blocks), dim3(256), args, 0, stream);
  if (e != hipSuccess) fprintf(stderr, "cooperative launch failed: %s (grid %d)\n", hipGetErrorString(e), grid_blocks);
}
```

```cpp
#include <hip/hip_runtime.h>
#include <hip/hip_cooperative_groups.h>
#include <cstdio>
namespace cg = cooperative_groups;

typedef unsigned short u16;
typedef __attribute__((ext_vector_type(8))) short bf16x8;
typedef __attribute__((ext_vector_type(16))) float f32x16;
typedef __attribute__((ext_vector_type(2))) float f32x2;
typedef __attribute__((ext_vector_type(4))) unsigned u32x4;
typedef __attribute__((ext_vector_type(2))) unsigned u32x2;
typedef __attribute__((ext_vector_type(2))) __bf16 bf16x2_t;

#define DI __device__ __forceinline__
#define MFMA32(a, b, c) __builtin_amdgcn_mfma_f32_32x32x16_bf16((a), (b), (c), 0, 0, 0)

constexpr int D_ = 1024;
constexpr int LP = 8208;
constexpr int TP = 16416;
constexpr int TS = 256;
constexpr int MT = TP + TS;
constexpr int M2 = 16640;
constexpr int LKS = 2064;
constexpr int TKS = 16 * LKS;
constexpr int CR = 1792;
constexpr int CIN = 2464;
constexpr int NRKV = 1536;
constexpr int NREST = 928;
constexpr int LDVP = TP + 64;
constexpr int LDVS = TKS + 64;

constexpr size_t OFF_WIN = 0;
constexpr size_t OFF_WQB = OFF_WIN + (size_t)CIN * 1024 * 2;
constexpr size_t OFF_WKN = OFF_WQB + (size_t)768 * 384 * 2;
constexpr size_t OFF_WV = OFF_WKN + (size_t)512 * 256 * 2;
constexpr size_t OFF_WDEC = OFF_WV + (size_t)512 * 256 * 2;
constexpr size_t OFF_WAAA = OFF_WDEC + (size_t)512 * 64 * 2;
constexpr size_t OFF_WGATE = OFF_WAAA + (size_t)512 * 64 * 2;
constexpr size_t OFF_WOUT = OFF_WGATE + (size_t)512 * 128 * 2;
constexpr size_t OFF_WUP = OFF_WOUT + (size_t)1024 * 1024 * 2;
constexpr size_t OFF_WDOWN = OFF_WUP + (size_t)4096 * 1024 * 2;
constexpr size_t OFF_PRKV = OFF_WDOWN + (size_t)4096 * 1024 * 2;
constexpr size_t OFF_R2 = OFF_PRKV + (size_t)MT * NRKV * 2;
constexpr size_t OFF_GG = OFF_R2 + (size_t)MT * 1024 * 2;
constexpr size_t OFF_Q = OFF_GG + (size_t)MT * 512 * 2;
constexpr size_t OFF_KNP = OFF_Q + (size_t)MT * 768 * 2;
constexpr size_t OFF_VTP = OFF_KNP + (size_t)(TP + 64) * 512 * 2;
constexpr size_t OFF_R6 = OFF_VTP + (size_t)512 * LDVP * 2;
constexpr size_t OFF_VTS = OFF_R6 + (size_t)(TKS + 64) * 512 * 2;
constexpr size_t OFF_KRP = OFF_VTS + (size_t)512 * LDVS * 2;
constexpr size_t OFF_KRS = OFF_KRP + (size_t)(TP + 64) * 32 * 2;
constexpr size_t OFF_ROPE = OFF_KRS + (size_t)(TKS + 64) * 32 * 2;
constexpr size_t OFF_STATS = OFF_ROPE + (size_t)LP * 16 * 4 * 2;
constexpr size_t OFF_CNT = OFF_STATS + (size_t)MT * 2 * 4;
constexpr size_t OFF_PRE8 = OFF_CNT + 8192;
constexpr size_t OFF_XB = OFF_PRE8 + (size_t)MT * 8 * 4;
constexpr size_t WS_END = OFF_XB + 16384;
static_assert(WS_END < (size_t)256 * 1024 * 1024, "ws overflow");
constexpr size_t OFF_OCAT = OFF_R6;
constexpr size_t OFF_H1B = OFF_PRKV;
constexpr size_t OFF_ACT = OFF_R2;
static_assert(OFF_ACT + (size_t)M2 * 4096 * 2 < (size_t)256 * 1024 * 1024, "act overflow");
static_assert((size_t)M2 * 1024 * 2 <= (size_t)MT * NRKV * 2, "h1b overflow");

constexpr size_t SC_AA = 0;
constexpr size_t SC_LIN = SC_AA + (size_t)MT * 512 * 2;
constexpr size_t SC_QN = SC_LIN + (size_t)MT * 256 * 2;
constexpr size_t SC_CBP = SC_QN + (size_t)MT * 384 * 2;
constexpr size_t SC_CBS = SC_CBP + (size_t)TP * 256 * 2;
constexpr size_t SC_END = SC_CBS + (size_t)TKS * 256 * 2;
static_assert(SC_END <= (size_t)2 * 8192 * 1024 * 4, "scratch overflow");
constexpr size_t SC_YB = SC_LIN;
constexpr size_t SC_OAT = SC_CBP;
static_assert(SC_YB + (size_t)MT * 512 * 2 <= SC_CBP, "yb overflow");
static_assert(SC_OAT + (size_t)MT * 512 * 2 <= SC_END, "oat overflow");

constexpr size_t O_Y = 0;
constexpr size_t O_LATP = (size_t)M2 * 1024;
constexpr size_t O_ROPEP = O_LATP + (size_t)TP * 256;
constexpr size_t O_STATEP = O_ROPEP + (size_t)TP * 32;
constexpr size_t O_SHIFTP = O_STATEP + (size_t)2 * 8 * 64 * 64;
constexpr size_t O_LATS = O_SHIFTP + (size_t)2 * CR;
constexpr size_t O_ROPES = O_LATS + (size_t)TS * 256;
constexpr size_t O_STATES = O_ROPES + (size_t)TS * 32;
constexpr size_t O_SHIFTS = O_STATES + (size_t)16 * 8 * 64 * 64;

constexpr float ALPHA = 1.189207115002721f;
constexpr float DECAY_SCALE = 0.6065306597126334f;
constexpr float QSCALE = 0.10206207261596577f * 1.4426950408889634f;

constexpr int SMEM_BYTES = 81472 + 64;

struct Params {
  const float* in[33];
  float* out;
  char* ws;
};

DI u16 f2bf(float f) { unsigned u = __float_as_uint(f); u += 0x7FFFu + ((u >> 16) & 1u); return (u16)(u >> 16); }
DI float bf2f(u16 h) { return __uint_as_float(((unsigned)h) << 16); }
DI unsigned pack2(float a, float b) {
  f32x2 v = {a, b};
  bf16x2_t r = __builtin_convertvector(v, bf16x2_t);
  return __builtin_bit_cast(unsigned, r);
}
template <int CTRL> DI float dppf(float x) {
  return __int_as_float(__builtin_amdgcn_mov_dpp(__float_as_int(x), CTRL, 0xF, 0xF, true));
}
DI float allreduce16(float x) {
  x += dppf<0xB1>(x);
  x += dppf<0x4E>(x);
  x += dppf<0x141>(x);
  x += dppf<0x140>(x);
  return x;
}
DI float allreduce32(float x) {
  x = allreduce16(x);
  auto t = __builtin_amdgcn_permlane16_swap(__float_as_uint(x), __float_as_uint(x), false, false);
  return __uint_as_float(t[0]) + __uint_as_float(t[1]);
}
DI float wave_sum(float x) {
  x = allreduce32(x);
  auto t = __builtin_amdgcn_permlane32_swap(__float_as_uint(x), __float_as_uint(x), false, false);
  return __uint_as_float(t[0]) + __uint_as_float(t[1]);
}
DI float sigmoidf_(float x) { return 1.0f / (1.0f + __expf(-x)); }
DI float tanhf_(float x) { float e = __expf(2.0f * x); return 1.0f - 2.0f / (e + 1.0f); }

constexpr int GLD = 72;
constexpr int GBUF = 256 * GLD;
template <class Epi>
__device__ __forceinline__ void gemm_tile(const u16* __restrict__ A, int lda, const u16* __restrict__ Bt, int ldb,
                          int M, int N, int K, int m0, int n0, Epi& epi, u16* smem, int kbeg = 0) {
  u16* As = smem;
  u16* Bs = smem + 128 * GLD;
  const int tid = threadIdx.x, lane = tid & 63, wave = tid >> 6;
  const int wm = wave >> 1, wn = wave & 1;
  const int r = lane & 31, hh = lane >> 5;
  size_t aoff[4], boff[4];
  int soff[4];
#pragma unroll
  for (int i = 0; i < 4; ++i) {
    int c = tid + 256 * i;
    int row = c >> 3, kc = c & 7;
    int ar = m0 + row; ar = ar < M ? ar : M - 1;
    int br = n0 + row; br = br < N ? br : N - 1;
    aoff[i] = (size_t)ar * lda + kc * 8 + kbeg;
    boff[i] = (size_t)br * ldb + kc * 8 + kbeg;
    soff[i] = row * GLD + kc * 8;
  }
  struct GRegs { u32x4 a[4], b[4]; };
  auto prefetch = [&](GRegs& R, int kt) {
#pragma unroll
    for (int i = 0; i < 4; ++i) {
      R.a[i] = *(const u32x4*)(A + aoff[i] + (size_t)kt * 64);
      R.b[i] = *(const u32x4*)(Bt + boff[i] + (size_t)kt * 64);
    }
  };
  auto lds_write = [&](const GRegs& R, int buf) {
#pragma unroll
    for (int i = 0; i < 4; ++i) {
      *(u32x4*)(As + buf * GBUF + soff[i]) = R.a[i];
      *(u32x4*)(Bs + buf * GBUF + soff[i]) = R.b[i];
    }
  };
  f32x16 acc[2][2];
#pragma unroll
  for (int i = 0; i < 2; ++i)
#pragma unroll
    for (int j = 0; j < 2; ++j)
#pragma unroll
      for (int e = 0; e < 16; ++e) acc[i][j][e] = 0.f;
  auto compute = [&](int buf) {
    const u16* Ab = As + buf * GBUF;
    const u16* Bb = Bs + buf * GBUF;
#pragma unroll
    for (int ks = 0; ks < 4; ++ks) {
      bf16x8 af[2], bfr[2];
#pragma unroll
      for (int i = 0; i < 2; ++i) {
        af[i] = *(const bf16x8*)(Ab + (wm * 64 + i * 32 + r) * GLD + ks * 16 + hh * 8);
        bfr[i] = *(const bf16x8*)(Bb + (wn * 64 + i * 32 + r) * GLD + ks * 16 + hh * 8);
      }
#pragma unroll
      for (int i = 0; i < 2; ++i)
#pragma unroll
        for (int j = 0; j < 2; ++j) acc[i][j] = MFMA32(af[i], bfr[j], acc[i][j]);
    }
  };
  const int nk = K >> 6;
  GRegs RA, RB;
  prefetch(RA, 0);
  if (1 < nk) prefetch(RB, 1);
  lds_write(RA, 0);
  __syncthreads();
  for (int kt = 0; kt < nk; kt += 2) {
    if (kt + 2 < nk) prefetch(RA, kt + 2);
    compute(0);
    if (kt + 1 < nk) lds_write(RB, 1);
    __syncthreads();
    if (kt + 1 < nk) {
      if (kt + 3 < nk) prefetch(RB, kt + 3);
      compute(1);
      if (kt + 2 < nk) lds_write(RA, 0);
      __syncthreads();
    }
  }
#pragma unroll
  for (int i = 0; i < 2; ++i)
#pragma unroll
    for (int j = 0; j < 2; ++j) {
      const int col = n0 + wn * 64 + j * 32 + r;
#pragma unroll
      for (int e = 0; e < 16; ++e) {
        const int row = m0 + wm * 64 + i * 32 + (e & 3) + 8 * (e >> 2) + 4 * hh;
        epi(row, col, acc[i][j][e], (row < M) && (col < N));
      }
    }
}

template <class Epi, class Map>
__device__ __forceinline__ void gemm_phase(const u16* __restrict__ A, int lda, const u16* __restrict__ Bt, int ldb,
                                           int M, int N, int K, int ntiles, Map tmap, Epi& epi, u16* smem) {
  u16* As = smem;
  u16* Bs = smem + 128 * GLD;
  const int tid = threadIdx.x, lane = tid & 63, wave = tid >> 6;
  const int wm = wave >> 1, wn = wave & 1;
  const int r = lane & 31, hh = lane >> 5;
  int t = blockIdx.x;
  if (t >= ntiles) return;
  size_t aoff[4], boff[4];
  int soff[4];
#pragma unroll
  for (int i = 0; i < 4; ++i) { int c = tid + 256 * i; soff[i] = (c >> 3) * GLD + (c & 7) * 8; }
  auto set_tile = [&](int m0, int n0) {
#pragma unroll
    for (int i = 0; i < 4; ++i) {
      int c = tid + 256 * i;
      int row = c >> 3, kc = c & 7;
      int ar = m0 + row; ar = ar < M ? ar : M - 1;
      int br = n0 + row; br = br < N ? br : N - 1;
      aoff[i] = (size_t)ar * lda + kc * 8;
      boff[i] = (size_t)br * ldb + kc * 8;
    }
  };
  struct GRegs { u32x4 a[4], b[4]; };
  auto prefetch = [&](GRegs& R, int kt) {
#pragma unroll
    for (int i = 0; i < 4; ++i) {
      R.a[i] = *(const u32x4*)(A + aoff[i] + (size_t)kt * 64);
      R.b[i] = *(const u32x4*)(Bt + boff[i] + (size_t)kt * 64);
    }
  };
  auto lds_write = [&](const GRegs& R, int buf) {
#pragma unroll
    for (int i = 0; i < 4; ++i) {
      *(u32x4*)(As + buf * GBUF + soff[i]) = R.a[i];
      *(u32x4*)(Bs + buf * GBUF + soff[i]) = R.b[i];
    }
  };
  const int nk = K >> 6;
  GRegs RA, RB;
  int m0, n0;
  tmap(t, m0, n0);
  set_tile(m0, n0);
  prefetch(RA, 0);
  prefetch(RB, 1);
  for (;;) {
    f32x16 acc[2][2];
#pragma unroll
    for (int i = 0; i < 2; ++i)
#pragma unroll
      for (int j = 0; j < 2; ++j)
#pragma unroll
        for (int e = 0; e < 16; ++e) acc[i][j][e] = 0.f;
    auto compute = [&](int buf) {
      const u16* Ab = As + buf * GBUF;
      const u16* Bb = Bs + buf * GBUF;
#pragma unroll
      for (int ks = 0; ks < 4; ++ks) {
        bf16x8 af[2], bfr[2];
#pragma unroll
        for (int i = 0; i < 2; ++i) {
          af[i] = *(const bf16x8*)(Ab + (wm * 64 + i * 32 + r) * GLD + ks * 16 + hh * 8);
          bfr[i] = *(const bf16x8*)(Bb + (wn * 64 + i * 32 + r) * GLD + ks * 16 + hh * 8);
        }
#pragma unroll
        for (int i = 0; i < 2; ++i)
#pragma unroll
          for (int j = 0; j < 2; ++j) acc[i][j] = MFMA32(af[i], bfr[j], acc[i][j]);
      }
    };
    lds_write(RA, 0);
    __syncthreads();
    for (int kt = 0; kt < nk; kt += 2) {
      if (kt + 2 < nk) prefetch(RA, kt + 2);
      compute(0);
      lds_write(RB, 1);
      __syncthreads();
      if (kt + 3 < nk) prefetch(RB, kt + 3);
      compute(1);
      if (kt + 2 < nk) lds_write(RA, 0);
      __syncthreads();
    }
    const int tn = t + (int)gridDim.x;
    const bool more = tn < ntiles;
    const int cm0 = m0, cn0 = n0;
    if (more) {
      tmap(tn, m0, n0);
      set_tile(m0, n0);
      prefetch(RA, 0);
    }
#pragma unroll
    for (int i = 0; i < 2; ++i)
#pragma unroll
      for (int j = 0; j < 2; ++j) {
        const int col = cn0 + wn * 64 + j * 32 + r;
#pragma unroll
        for (int e = 0; e < 16; ++e) {
          const int row = cm0 + wm * 64 + i * 32 + (e & 3) + 8 * (e >> 2) + 4 * hh;
          epi(row, col, acc[i][j][e], (row < M) && (col < N));
        }
      }
    if (!more) break;
    prefetch(RB, 1);
    t = tn;
  }
}

struct EpiInproj {
  u16* prkv; u16* prest; float* out;
  DI void operator()(int row, int col, float v, bool valid) const {
    if (!valid) return;
    if (col < NRKV) prkv[(size_t)row * NRKV + col] = f2bf(v);
    else prest[(size_t)row * NREST + (col - NRKV)] = f2bf(v);
    if (col < CR) {
      if (row < TP) {
        if (row == LP - 1) out[O_SHIFTP + col] = v;
        else if (row == 2 * LP - 1) out[O_SHIFTP + CR + col] = v;
      } else {
        int s = row - TP;
        if ((s & 15) == 15) out[O_SHIFTS + (size_t)(s >> 4) * CR + col] = v;
      }
    }
  }
};
struct EpiDecay {
  float* wd; const float* base;
  DI void operator()(int row, int col, float v, bool valid) const {
    if (valid) wd[(size_t)row * 512 + col] = __expf(-DECAY_SCALE * sigmoidf_(base[col] + v));
  }
};
struct EpiAaa {
  u16* aa; const float* base;
  DI void operator()(int row, int col, float v, bool valid) const {
    if (valid) aa[(size_t)row * 512 + col] = f2bf(sigmoidf_(base[col] + v));
  }
};
struct EpiStoreBf {
  u16* dst; int ld;
  DI void operator()(int row, int col, float v, bool valid) const {
    if (valid) dst[(size_t)row * ld + col] = f2bf(v);
  }
};
struct EpiQ {
  u16* q; const float* cosT; const float* sinT;
  DI void operator()(int row, int col, float v, bool valid) const {
    int dcol = col % 96;
    float partner = __shfl_xor(v, 16);
    if (dcol >= 64) {
      int rr = row < MT ? row : MT - 1;
      int pos = rr < TP ? (rr % LP) : 2048 + ((rr - TP) & 15);
      int i = (dcol - 64) & 15;
      float c = cosT[pos * 16 + i], s = sinT[pos * 16 + i];
      v = (dcol < 80) ? (v * c - partner * s) : (partner * s + v * c);
    }
    if (valid) q[(size_t)row * 768 + col] = f2bf(v * QSCALE);
  }
};
struct EpiOut {
  const float* x; const float* xs; const float* stats; const float* g; const float* b; float* out;
  DI void operator()(int row, int col, float v, bool valid) const {
    if (!valid) return;
    int m = row < 16384 ? ((row >> 13) * LP + 16 + (row & 8191)) : (TP + row - 16384);
    float mu = stats[2 * m], rs = stats[2 * m + 1];
    const float xv = row < 16384 ? x[(size_t)row * 1024 + col] : xs[(size_t)(row - 16384) * 1024 + col];
    float h = (xv - mu) * rs * g[col] + b[col];
    out[(size_t)row * 1024 + col] = ALPHA * h + v;
  }
};
struct EpiUp {
  u16* act;
  DI void operator()(int row, int col, float v, bool valid) const {
    if (valid) { float t = v > 0.f ? v : 0.f; act[(size_t)row * 4096 + col] = f2bf(t * t); }
  }
};
struct EpiDown {
  float* out;
  DI void operator()(int row, int col, float v, bool valid) const {
    if (valid) { size_t o = (size_t)row * 1024 + col; out[o] = out[o] + v; }
  }
};
struct EpiDownAtomic {
  float* out;
  DI void operator()(int row, int col, float v, bool valid) const {
    if (valid) atomicAdd(out + (size_t)row * 1024 + col, v);
  }
};

__device__ __forceinline__ void transpose_tiles(const float* __restrict__ src, int ld_src, u16* __restrict__ dst, int K, int Nd, int mode,
                                float* tl) {
  const int tid = threadIdx.x, tx = tid & 31, ty = tid >> 5;
  const int ntn = Nd >> 5, ntk = K >> 5, nt = ntn * ntk;
  const int G = gridDim.x;
  for (int t0 = blockIdx.x; t0 < nt; t0 += 4 * G) {
    float v[4][4];
#pragma unroll
    for (int u = 0; u < 4; ++u) {
      int t = t0 + u * G; t = t < nt ? t : t0;
      const int tn = t % ntn, tk = t / ntn;
      const int n = tn * 32 + tx, k0 = tk * 32;
      const int sc = mode == 0 ? n : ((n >> 6) * 128 + (n & 63) + (mode == 2 ? 64 : 0));
#pragma unroll
      for (int i = 0; i < 4; ++i) v[u][i] = src[(size_t)(k0 + ty + 8 * i) * ld_src + sc];
    }
#pragma unroll
    for (int u = 0; u < 4; ++u)
#pragma unroll
      for (int i = 0; i < 4; ++i) tl[u * 1056 + (ty + 8 * i) * 33 + tx] = v[u][i];
    __syncthreads();
#pragma unroll
    for (int u = 0; u < 4; ++u) {
      const int t = t0 + u * G;
      if (t < nt) {
        const int tn = t % ntn, tk = t / ntn;
        const int n0 = tn * 32, k0 = tk * 32;
#pragma unroll
        for (int i = 0; i < 4; ++i) {
          const int nn = ty + 8 * i;
          dst[(size_t)(n0 + nn) * K + k0 + tx] = f2bf(tl[u * 1056 + tx * 33 + nn]);
        }
      }
    }
    __syncthreads();
  }
}

__device__ __forceinline__ void phase_prep(const Params& p, char* smem) {
  char* ws = p.ws;
  float* tl = (float*)smem;
  transpose_tiles(p.in[9], CIN, (u16*)(ws + OFF_WIN), 1024, CIN, 0, tl);
  transpose_tiles(p.in[22], 768, (u16*)(ws + OFF_WQB), 384, 768, 0, tl);
  transpose_tiles(p.in[24], 1024, (u16*)(ws + OFF_WKN), 256, 512, 1, tl);
  transpose_tiles(p.in[24], 1024, (u16*)(ws + OFF_WV), 256, 512, 2, tl);
  transpose_tiles(p.in[11], 512, (u16*)(ws + OFF_WDEC), 64, 512, 0, tl);
  transpose_tiles(p.in[13], 512, (u16*)(ws + OFF_WAAA), 64, 512, 0, tl);
  transpose_tiles(p.in[15], 512, (u16*)(ws + OFF_WGATE), 128, 512, 0, tl);
  transpose_tiles(p.in[26], 1024, (u16*)(ws + OFF_WOUT), 1024, 1024, 0, tl);
  transpose_tiles(p.in[29], 4096, (u16*)(ws + OFF_WUP), 1024, 4096, 0, tl);
  transpose_tiles(p.in[30], 1024, (u16*)(ws + OFF_WDOWN), 4096, 1024, 0, tl);

  const int tid = threadIdx.x, lane = tid & 63, wave = tid >> 6;
  {
    u16* Hb = (u16*)(ws + OFF_R2);
    float* stats = (float*)(ws + OFF_STATS);
    const float* g = p.in[7]; const float* bb = p.in[8];
    auto rowsrc = [&](int m) -> const float* {
      if (m < TP) { int b = m / LP, l = m % LP; return l < 16 ? p.in[6] + (size_t)l * 1024 : p.in[0] + ((size_t)b * 8192 + (l - 16)) * 1024; }
      return p.in[1] + (size_t)(m - TP) * 1024;
    };
    const int stride = gridDim.x * 4;
    int m = blockIdx.x * 4 + wave;
    float4 v[4], vn[4];
    if (m < MT) {
      const float* src = rowsrc(m);
#pragma unroll
      for (int i = 0; i < 4; ++i) v[i] = *(const float4*)(src + lane * 4 + 256 * i);
    }
    for (; m < MT; m += stride) {
      const int mn = m + stride;
      {
        const float* srcn = rowsrc(mn < MT ? mn : m);
#pragma unroll
        for (int i = 0; i < 4; ++i) vn[i] = *(const float4*)(srcn + lane * 4 + 256 * i);
      }
      float s = 0.f;
#pragma unroll
      for (int i = 0; i < 4; ++i) s += v[i].x + v[i].y + v[i].z + v[i].w;
      float mu = wave_sum(s) * (1.0f / 1024.0f);
      float q = 0.f;
#pragma unroll
      for (int i = 0; i < 4; ++i) { float a = v[i].x - mu, b2 = v[i].y - mu, c = v[i].z - mu, d = v[i].w - mu; q += a * a + b2 * b2 + c * c + d * d; }
      float rs = rsqrtf(wave_sum(q) * (1.0f / 1024.0f) + 1e-5f);
      if (lane == 0) { stats[2 * m] = mu; stats[2 * m + 1] = rs; }
#pragma unroll
      for (int i = 0; i < 4; ++i) {
        int c = lane * 4 + 256 * i;
        float4 gg = *(const float4*)(g + c), b4 = *(const float4*)(bb + c);
        uint2 o;
        o.x = pack2((v[i].x - mu) * rs * gg.x + b4.x, (v[i].y - mu) * rs * gg.y + b4.y);
        o.y = pack2((v[i].z - mu) * rs * gg.z + b4.z, (v[i].w - mu) * rs * gg.w + b4.w);
        *(uint2*)(Hb + (size_t)m * 1024 + c) = o;
      }
#pragma unroll
      for (int i = 0; i < 4; ++i) v[i] = vn[i];
    }
  }
  const size_t gtid = (size_t)blockIdx.x * 256 + tid, gsz = (size_t)gridDim.x * 256;
  {
    float* cosT = (float*)(ws + OFF_ROPE); float* sinT = cosT + LP * 16;
    for (size_t e = gtid; e < (size_t)LP * 16; e += gsz) {
      int pos = (int)(e >> 4), i = (int)(e & 15);
      double inv = exp(-(double)(2 * i) / 32.0 * 9.210340371976184);
      double rev = (double)pos * inv * 0.15915494309189535;
      rev -= rint(rev);
      float rf = (float)rev;
      cosT[e] = __builtin_amdgcn_cosf(rf);
      sinT[e] = __builtin_amdgcn_sinf(rf);
    }
  }
  {
    u16* CbS = (u16*)((char*)p.out + SC_CBS);
    const float* cl = p.in[2];
    for (size_t e0 = gtid; e0 < (size_t)16 * 2048 * 64; e0 += 4 * gsz) {
      float4 v[4]; size_t ee[4];
#pragma unroll
      for (int u = 0; u < 4; ++u) {
        ee[u] = e0 + u * gsz; if (ee[u] >= (size_t)16 * 2048 * 64) ee[u] = e0;
        v[u] = *(const float4*)(cl + (ee[u] >> 6) * 256 + (ee[u] & 63) * 4);
      }
#pragma unroll
      for (int u = 0; u < 4; ++u) {
        size_t row = ee[u] >> 6; int c4 = (int)(ee[u] & 63);
        int b = (int)(row >> 11), key = (int)(row & 2047);
        uint2 o; o.x = pack2(v[u].x, v[u].y); o.y = pack2(v[u].z, v[u].w);
        *(uint2*)(CbS + ((size_t)b * LKS + key) * 256 + c4 * 4) = o;
      }
    }
    u16* KRs = (u16*)(ws + OFF_KRS);
    const float* cr = p.in[3];
    for (size_t e = gtid; e < (size_t)16 * 2048 * 8; e += gsz) {
      size_t row = e >> 3; int c4 = (int)(e & 7);
      int b = (int)(row >> 11), key = (int)(row & 2047);
      float4 v = *(const float4*)(cr + row * 32 + c4 * 4);
      uint2 o; o.x = pack2(v.x, v.y); o.y = pack2(v.z, v.w);
      *(uint2*)(KRs + ((size_t)b * LKS + key) * 32 + c4 * 4) = o;
    }
  }
}

__device__ __forceinline__ void phase_postproj(const Params& p) {
  char* ws = p.ws;
  const int lane = threadIdx.x & 63, wave = threadIdx.x >> 6;
  const u16* Prest = (const u16*)(ws + OFF_R6);
  u16* Lin = (u16*)((char*)p.out + SC_LIN);
  u16* Qn = (u16*)((char*)p.out + SC_QN);
  u16* CbP = (u16*)((char*)p.out + SC_CBP);
  u16* CbS = (u16*)((char*)p.out + SC_CBS);
  u16* KRp = (u16*)(ws + OFF_KRP);
  u16* KRs = (u16*)(ws + OFF_KRS);
  const float* cosT = (const float*)(ws + OFF_ROPE); const float* sinT = cosT + LP * 16;
  const float* mu_shift = p.in[10];
  const float* sshift = p.in[5];
  const float* qg = p.in[21]; const float* kvg = p.in[23];
  for (int m = blockIdx.x * 4 + wave; m < MT; m += gridDim.x * 4) {
    const bool prompt = m < TP;
    int b, l;
    if (prompt) { b = m / LP; l = m % LP; } else { b = (m - TP) >> 4; l = (m - TP) & 15; }
    const u16* row = Prest + (size_t)m * NREST;
#pragma unroll
    for (int i = 0; i < 4; ++i) {
      int c = lane + 64 * i;
      float cur = bf2f(row[c]);
      float prev;
      if (l > 0) prev = bf2f(row[c - NREST]);
      else prev = prompt ? 0.f : sshift[(size_t)b * CR + NRKV + c];
      float x = cur + mu_shift[NRKV + c] * (prev - cur);
      float o = i == 0 ? tanhf_(x) : (i == 1 ? x : sigmoidf_(x));
      Lin[(size_t)m * 256 + c] = f2bf(o);
    }
    {
      float v[6]; float ss = 0.f;
#pragma unroll
      for (int i = 0; i < 6; ++i) { v[i] = bf2f(row[256 + lane + 64 * i]); ss += v[i] * v[i]; }
      float rs = rsqrtf(wave_sum(ss) * (1.0f / 384.0f) + 1e-6f);
#pragma unroll
      for (int i = 0; i < 6; ++i) Qn[(size_t)m * 384 + lane + 64 * i] = f2bf(v[i] * rs * qg[lane + 64 * i]);
    }
    {
      float v[4]; float ss = 0.f;
#pragma unroll
      for (int i = 0; i < 4; ++i) { v[i] = bf2f(row[640 + lane + 64 * i]); ss += v[i] * v[i]; }
      float rs = rsqrtf(wave_sum(ss) * (1.0f / 256.0f) + 1e-6f);
      float* lo = prompt ? p.out + O_LATP + (size_t)m * 256 : p.out + O_LATS + (size_t)(m - TP) * 256;
      u16* cb = prompt ? CbP + (size_t)m * 256 : CbS + ((size_t)b * LKS + 2048 + l) * 256;
#pragma unroll
      for (int i = 0; i < 4; ++i) {
        float c = v[i] * rs * kvg[lane + 64 * i];
        lo[lane + 64 * i] = c;
        cb[lane + 64 * i] = f2bf(c);
      }
    }
    {
      int i = lane & 15;
      float x1 = bf2f(row[896 + i]), x2 = bf2f(row[912 + i]);
      int pos = prompt ? l : 2048 + l;
      float c = cosT[pos * 16 + i], s = sinT[pos * 16 + i];
      float o1 = x1 * c - x2 * s, o2 = x1 * s + x2 * c;
      float* ro = prompt ? p.out + O_ROPEP + (size_t)m * 32 : p.out + O_ROPES + (size_t)(m - TP) * 32;
      u16* kr = prompt ? KRp + (size_t)m * 32 : KRs + ((size_t)b * LKS + 2048 + l) * 32;
      if (lane < 16) { ro[i] = o1; ro[16 + i] = o2; kr[i] = f2bf(o1); kr[16 + i] = f2bf(o2); }
    }
  }
}

struct ShiftSave { unsigned d[12]; };
__device__ __forceinline__ void shift_save(const Params& p, ShiftSave& sv) {
  const int lane = threadIdx.x & 63, wave = threadIdx.x >> 6;
  const int tpw = (MT + (int)gridDim.x * 4 - 1) / ((int)gridDim.x * 4);
  const int m_lo = (blockIdx.x * 4 + wave) * tpw;
  const unsigned* Pd = (const unsigned*)(p.ws + OFF_PRKV);
  const int mr = (m_lo > 0 && m_lo < MT) ? m_lo - 1 : 0;
#pragma unroll
  for (int i = 0; i < 12; ++i) sv.d[i] = Pd[(size_t)mr * (NRKV / 2) + lane + 64 * i];
}
__device__ __forceinline__ void shift_apply(const Params& p, const ShiftSave& sv) {
  const int lane = threadIdx.x & 63, wave = threadIdx.x >> 6;
  const int tpw = (MT + (int)gridDim.x * 4 - 1) / ((int)gridDim.x * 4);
  const int m_lo = (blockIdx.x * 4 + wave) * tpw;
  if (m_lo >= MT) return;
  const int m_hi = (m_lo + tpw < MT) ? m_lo + tpw : MT;
  unsigned* Pd = (unsigned*)(p.ws + OFF_PRKV);
  float* PRE8 = (float*)(p.ws + OFF_PRE8);
  const float* mu = p.in[10];
  const float* k_k = p.in[16];
  for (int m = m_hi - 1; m >= m_lo; --m) {
    const bool prompt = m < TP;
    int b, l;
    if (prompt) { b = m / LP; l = m % LP; } else { b = (m - TP) >> 4; l = (m - TP) & 15; }
    unsigned* row = Pd + (size_t)m * (NRKV / 2);
    unsigned cur[12], prv[12];
#pragma unroll
    for (int i = 0; i < 12; ++i) cur[i] = row[lane + 64 * i];
    if (l > 0 && m > m_lo) {
#pragma unroll
      for (int i = 0; i < 12; ++i) prv[i] = row[lane + 64 * i - NRKV / 2];
    } else {
#pragma unroll
      for (int i = 0; i < 12; ++i) prv[i] = sv.d[i];
    }
#pragma unroll
    for (int i = 0; i < 12; ++i) {
      const int c = 2 * (lane + 64 * i);
      float c0 = __uint_as_float(cur[i] << 16), c1 = __uint_as_float(cur[i] & 0xFFFF0000u);
      float p0 = __uint_as_float(prv[i] << 16), p1 = __uint_as_float(prv[i] & 0xFFFF0000u);
      if (l == 0) {
        if (prompt) { p0 = 0.f; p1 = 0.f; }
        else { const float2 q = *(const float2*)(p.in[5] + (size_t)b * CR + c); p0 = q.x; p1 = q.y; }
      }
      const float2 mm = *(const float2*)(mu + c);
      const float o0 = c0 + mm.x * (p0 - c0), o1 = c1 + mm.y * (p1 - c1);
      row[lane + 64 * i] = pack2(o0, o1);
      if (i >= 4 && i < 8) {
        const float2 kw = *(const float2*)(k_k + c - 512);
        const float q0 = o0 * kw.x, q1 = o1 * kw.y;
        const float ss = allreduce32(fmaf(q0, q0, q1 * q1));
        if ((lane & 31) == 0) PRE8[(size_t)m * 8 + 2 * (i - 4) + (lane >> 5)] = __builtin_amdgcn_rsqf(fmaxf(ss, 1e-24f));
      }
    }
  }
}

__device__ __forceinline__ void phase_gemms3(const Params& p, u16* smem) {
  char* ws = p.ws;
  const u16* Lin = (const u16*)((char*)p.out + SC_LIN);
  const u16* Qn = (const u16*)((char*)p.out + SC_QN);
  const u16* CbP = (const u16*)((char*)p.out + SC_CBP);
  const u16* CbS = (const u16*)((char*)p.out + SC_CBS);
  constexpr int TM = (MT + 127) / 128;
  constexpr int TMP = (TP + 127) / 128;
  constexpr int TMS = TKS / 128;
  constexpr int J0 = TM * 4, J1 = J0 + TM * 4, J2 = J1 + TM * 4, J3 = J2 + TM * 6, J4 = J3 + TMP * 4, J5 = J4 + TMP * 4,
                J6 = J5 + TMS * 4, J7 = J6 + TMS * 4;
  for (int t = blockIdx.x; t < J7; t += gridDim.x) {
    if (t < J0) {
      EpiDecay e{(float*)(ws + OFF_R2), p.in[12]};
      gemm_tile(Lin, 256, (const u16*)(ws + OFF_WDEC), 64, MT, 512, 64, (t >> 2) * 128, (t & 3) * 128, e, smem);
    } else if (t < J1) {
      int u = t - J0;
      EpiAaa e{(u16*)((char*)p.out + SC_AA), p.in[14]};
      gemm_tile(Lin + 64, 256, (const u16*)(ws + OFF_WAAA), 64, MT, 512, 64, (u >> 2) * 128, (u & 3) * 128, e, smem);
    } else if (t < J2) {
      int u = t - J1;
      EpiStoreBf e{(u16*)(ws + OFF_GG), 512};
      gemm_tile(Lin + 128, 256, (const u16*)(ws + OFF_WGATE), 128, MT, 512, 128, (u >> 2) * 128, (u & 3) * 128, e, smem);
    } else if (t < J3) {
      int u = t - J2;
      EpiQ e{(u16*)(ws + OFF_Q), (const float*)(ws + OFF_ROPE), (const float*)(ws + OFF_ROPE) + LP * 16};
      gemm_tile(Qn, 384, (const u16*)(ws + OFF_WQB), 384, MT, 768, 384, (u / 6) * 128, (u % 6) * 128, e, smem);
    } else if (t < J4) {
      int u = t - J3;
      EpiStoreBf e{(u16*)(ws + OFF_KNP), 512};
      gemm_tile(CbP, 256, (const u16*)(ws + OFF_WKN), 256, TP, 512, 256, (u >> 2) * 128, (u & 3) * 128, e, smem);
    } else if (t < J5) {
      int u = t - J4;
      EpiStoreBf e{(u16*)(ws + OFF_VTP), LDVP};
      gemm_tile((const u16*)(ws + OFF_WV), 256, CbP, 256, 512, TP, 256, (u & 3) * 128, (u >> 2) * 128, e, smem);
    } else if (t < J6) {
      int u = t - J5;
      EpiStoreBf e{(u16*)(ws + OFF_R6), 512};
      gemm_tile(CbS, 256, (const u16*)(ws + OFF_WKN), 256, TKS, 512, 256, (u >> 2) * 128, (u & 3) * 128, e, smem);
    } else {
      int u = t - J6;
      EpiStoreBf e{(u16*)(ws + OFF_VTS), LDVS};
      gemm_tile((const u16*)(ws + OFF_WV), 256, CbS, 256, 512, TKS, 256, (u & 3) * 128, (u >> 2) * 128, e, smem);
    }
  }
}

constexpr int SB_A4 = 0, SB_B4 = 2816, SB_VV = 5632, SB_SIZE = 5712;
constexpr int SB_YP = 2 * SB_SIZE, SB_YPSZ = 64 * 36;
DI float afma(float a, float b, float c) { float r; asm("v_fma_f32 %0, %1, %2, %3" : "=v"(r) : "v"(a), "v"(b), "v"(c)); return r; }
DI float amul(float a, float b) { float r; asm("v_mul_f32 %0, %1, %2" : "=v"(r) : "v"(a), "v"(b)); return r; }
DI void lds_barrier() { asm volatile("s_waitcnt lgkmcnt(0)\n\ts_barrier" ::: "memory"); }
DI float bflo(unsigned u) { return __uint_as_float(u << 16); }
DI float bfhi(unsigned u) { return __uint_as_float(u & 0xFFFF0000u); }
struct ScanRaw { unsigned rs[4], ks[4], av[4]; float2 wv[4]; float inv[4]; float vs; };
__device__ __forceinline__ void scan_item(const Params& p, bool prompt, int b, int h, int grp, float* smem) {
  char* ws = p.ws;
  const int tid = threadIdx.x, lane = tid & 63, wave = tid >> 6;
  const u16* Prkv = (const u16*)(ws + OFF_PRKV);
  const float* Wd = (const float*)(ws + OFF_R2);
  const u16* Aa = (const u16*)((const char*)p.out + SC_AA);
  u16* Yb = (u16*)((char*)p.out + SC_YB);
  const int L = prompt ? LP : 16;
  const int nchunks = L / 16;
  const size_t mbase = prompt ? (size_t)b * LP : (size_t)TP + b * 16;
  const int c2 = lane & 31, ts = lane >> 5;

  if (wave < 2) {
    const int row4 = wave * 2 + ts;
    const int irow = grp * 4 + row4;
    const size_t sidx = (((size_t)b * 8 + h) * 64 + irow) * 64 + c2 * 2;
    float s0 = 0.f, s1 = 0.f;
    if (!prompt) { float2 t = *(const float2*)(p.in[4] + sidx); s0 = t.x; s1 = t.y; }
    lds_barrier();
    for (int c = 0; c < nchunks; ++c) {
      const float* pa = smem + (c & 1) * SB_SIZE + SB_A4 + c2 * 4;
      const float* pb = smem + (c & 1) * SB_SIZE + SB_B4 + c2 * 4;
      const float* pv = smem + (c & 1) * SB_SIZE + SB_VV + row4 * 20;
      float* py = smem + SB_YP + (c & 1) * SB_YPSZ + row4 * 36 + c2;
      float4 Aq[6], Bq[6];
      float4 Vc = *(const float4*)(pv), Vn = *(const float4*)(pv + 4);
#pragma unroll
      for (int i = 0; i < 6; ++i) {
        Aq[i] = *(const float4*)(pa + i * 128); Bq[i] = *(const float4*)(pb + i * 128);
      }
#pragma unroll
      for (int t = 0; t < 16; ++t) {
        const int sl = t % 6, vl = t & 3;
        if (vl == 0 && t > 0) { Vc = Vn; Vn = *(const float4*)(pv + t + 4); }
        const float4 A0 = Aq[sl], B0 = Bq[sl];
        const float v0 = vl == 0 ? Vc.x : (vl == 1 ? Vc.y : (vl == 2 ? Vc.z : Vc.w));
        Aq[sl] = *(const float4*)(pa + (t + 6) * 128); Bq[sl] = *(const float4*)(pb + (t + 6) * 128);
        const float a0 = bflo(__float_as_uint(A0.z)), a1 = bfhi(__float_as_uint(A0.z));
        const float2 R0 = make_float2(bflo(__float_as_uint(A0.w)), bfhi(__float_as_uint(A0.w)));
        float sa = amul(s0, a0) + amul(s1, a1);
        const float d0 = afma(v0, B0.z, amul(s0, A0.x)), d1 = afma(v0, B0.w, amul(s1, A0.y));
        sa = allreduce32(sa);
        s0 = afma(sa, B0.x, d0); s1 = afma(sa, B0.y, d1);
        py[t * 144] = amul(s0, R0.x) + amul(s1, R0.y);
      }
      lds_barrier();
    }
    float* so = p.out + (prompt ? O_STATEP : O_STATES) + sidx;
    *(float2*)so = make_float2(s0, s1);
  } else {
    const int ubeg = wave == 2 ? 0 : 4;
    const int hc = h * 64 + 2 * c2;
    const float2 kkw = *(const float2*)(p.in[16] + hc), kaw = *(const float2*)(p.in[17] + hc);
    const int vr4 = lane & 3, vtt = lane >> 2;
    const int vcol = h * 64 + grp * 4 + vr4;
    const float* PRE8 = (const float*)(ws + OFF_PRE8);
    auto prefetch = [&](ScanRaw& R, int chunk) {
      chunk = chunk < nchunks ? chunk : nchunks - 1;
      const int t0 = chunk * 16;
#pragma unroll
      for (int i = 0; i < 4; ++i) {
        const size_t m = mbase + t0 + 2 * (ubeg + i) + ts;
        const u16* row = Prkv + m * NRKV;
        R.rs[i] = *(const unsigned*)(row + hc); R.ks[i] = *(const unsigned*)(row + 512 + hc);
        R.wv[i] = *(const float2*)(Wd + m * 512 + hc);
        R.av[i] = *(const unsigned*)(Aa + m * 512 + hc);
        R.inv[i] = PRE8[m * 8 + h];
      }
      R.vs = bf2f(Prkv[(mbase + t0 + vtt) * NRKV + 1024 + vcol]);
    };
    auto stage = [&](const ScanRaw& R, float* buf) {
#pragma unroll
      for (int i = 0; i < 4; ++i) {
        const int tt = 2 * (ubeg + i) + ts;
        const float r0 = bflo(R.rs[i]), r1 = bfhi(R.rs[i]);
        const float k0 = bflo(R.ks[i]), k1 = bfhi(R.ks[i]);
        const float a0 = bflo(R.av[i]), a1 = bfhi(R.av[i]);
        const float kk0 = k0 * kkw.x * R.inv[i], kk1 = k1 * kkw.y * R.inv[i];
        const float kt0 = k0 * (1.0f + (a0 - 1.0f) * kaw.x), kt1 = k1 * (1.0f + (a1 - 1.0f) * kaw.y);
        *(float4*)(buf + SB_A4 + (tt * 32 + c2) * 4) = make_float4(R.wv[i].x, R.wv[i].y, __uint_as_float(pack2(-kk0, -kk1)), __uint_as_float(R.rs[i]));
        *(float4*)(buf + SB_B4 + (tt * 32 + c2) * 4) = make_float4(kk0 * a0, kk1 * a1, kt0, kt1);
      }
      if (wave == 3) buf[SB_VV + vr4 * 20 + vtt] = R.vs;
    };
    auto yflush = [&](int chunk) {
      chunk = chunk < 0 ? 0 : chunk;
      const float4* yp = (const float4*)(smem + SB_YP + (chunk & 1) * SB_YPSZ + lane * 36);
      float4 acc = yp[0];
#pragma unroll
      for (int i = 1; i < 8; ++i) { const float4 q = yp[i]; acc.x += q.x; acc.y += q.y; acc.z += q.z; acc.w += q.w; }
      const float y = (acc.x + acc.y) + (acc.z + acc.w);
      Yb[(mbase + chunk * 16 + vtt) * 512 + vcol] = f2bf(y);
    };
    ScanRaw S0, S1;
    prefetch(S0, 0);
    prefetch(S1, 1);
    stage(S0, smem);
    prefetch(S0, 2);
    lds_barrier();
    int c = 0;
    for (; c + 1 < nchunks; c += 2) {
      stage(S1, smem + SB_SIZE);
      prefetch(S1, c + 3);
      if (wave == 2) yflush(c - 1);
      lds_barrier();
      stage(S0, smem);
      prefetch(S0, c + 4);
      if (wave == 2) yflush(c);
      lds_barrier();
    }
    if (wave == 2) yflush(c - 1);
    lds_barrier();
    if (wave == 2) yflush(nchunks - 1);
  }
  __syncthreads();
}

constexpr int KLD = 104;
constexpr int VLD = 68;
constexpr int ATT_BUF = 64 * KLD + 64 * VLD;
__device__ __forceinline__ void attn_item(const u16* __restrict__ Q, int qrow_lim, const u16* __restrict__ Kn, const u16* __restrict__ KR,
                          const u16* __restrict__ Vt, int ldv, int first_valid, int nk_lo, int nk_hi, u16* __restrict__ O,
                          int q_valid, u16* smem) {
  u16* Ks = smem;
  u16* Vs = smem + 64 * KLD;
  const int tid = threadIdx.x, lane = tid & 63, wave = tid >> 6;
  const int r = lane & 31, hh = lane >> 5;
  const int my_nk = wave < 2 ? nk_lo : nk_hi;
  auto ntiles = [&](int nk) { return nk <= first_valid ? 1 : 1 + (nk - first_valid + 63) / 64; };
  const int nt_all = ntiles(nk_hi);
  const int my_nt = (wave * 32 < q_valid) ? ntiles(my_nk) : 0;
  bf16x8 qf[6];
  {
    int qr = wave * 32 + r; qr = qr < qrow_lim ? qr : qrow_lim - 1;
    const u16* qp = Q + (size_t)qr * 768 + hh * 8;
#pragma unroll
    for (int ks = 0; ks < 6; ++ks) qf[ks] = *(const bf16x8*)(qp + ks * 16);
  }
  int kkey[3], kch[3];
#pragma unroll
  for (int i = 0; i < 3; ++i) { int id = tid + 256 * i; kkey[i] = id / 12; kch[i] = id % 12; }
  struct KVRegs { u32x4 rk[3]; u32x4 rv[2]; };
  auto prefetch = [&](KVRegs& R, int kt) {
    int start = kt == 0 ? 0 : first_valid + 64 * (kt - 1);
#pragma unroll
    for (int i = 0; i < 3; ++i) {
      size_t key = (size_t)(start + kkey[i]);
      const u16* src = kch[i] < 8 ? Kn + key * 512 + kch[i] * 8 : KR + key * 32 + (kch[i] - 8) * 8;
      R.rk[i] = *(const u32x4*)src;
    }
#pragma unroll
    for (int i = 0; i < 2; ++i) {
      int id = tid + 256 * i; int d = id >> 3, ch = id & 7;
      R.rv[i] = *(const u32x4*)(Vt + (size_t)d * ldv + start + ch * 8);
    }
  };
  auto lds_write = [&](const KVRegs& R, int buf) {
    u16* Kb = Ks + buf * ATT_BUF;
    u16* Vb = Vs + buf * ATT_BUF;
#pragma unroll
    for (int i = 0; i < 3; ++i) *(u32x4*)(Kb + kkey[i] * KLD + kch[i] * 8) = R.rk[i];
#pragma unroll
    for (int i = 0; i < 2; ++i) {
      int id = tid + 256 * i; int d = id >> 3, ch = id & 7;
      u32x2* dst = (u32x2*)(Vb + d * VLD + ch * 8);
      u32x2 t0 = {R.rv[i].x, R.rv[i].y}, t1 = {R.rv[i].z, R.rv[i].w};
      dst[0] = t0;
      dst[1] = t1;
    }
  };
  f32x16 o[2];
#pragma unroll
  for (int i = 0; i < 2; ++i)
#pragma unroll
    for (int e = 0; e < 16; ++e) o[i][e] = 0.f;
  float m_run = -1e30f, l_run = 0.f;
  auto compute = [&](int kt) {
    const u16* Kb = Ks + (kt & 1) * ATT_BUF;
    const u16* Vb = Vs + (kt & 1) * ATT_BUF;
    const int start = kt == 0 ? 0 : first_valid + 64 * (kt - 1);
    int tv = kt == 0 ? first_valid : 64;
    if (my_nk - start < tv) tv = my_nk - start;
    f32x16 s[2];
#pragma unroll
    for (int T = 0; T < 2; ++T)
#pragma unroll
      for (int e = 0; e < 16; ++e) s[T][e] = 0.f;
#pragma unroll
    for (int ks = 0; ks < 6; ++ks) {
#pragma unroll
      for (int T = 0; T < 2; ++T) {
        bf16x8 kf = *(const bf16x8*)(Kb + (T * 32 + r) * KLD + ks * 16 + hh * 8);
        s[T] = MFMA32(kf, qf[ks], s[T]);
      }
    }
    if (tv < 64) {
#pragma unroll
      for (int T = 0; T < 2; ++T)
#pragma unroll
        for (int e = 0; e < 16; ++e) {
          int kidx = T * 32 + (e & 3) + 8 * (e >> 2) + 4 * hh;
          if (kidx >= tv) s[T][e] = -1e30f;
        }
    }
    float mx = s[0][0];
#pragma unroll
    for (int T = 0; T < 2; ++T)
#pragma unroll
      for (int e = 0; e < 16; ++e) mx = fmaxf(mx, s[T][e]);
    mx = fmaxf(mx, __shfl_xor(mx, 32));
    const float m_new = fmaxf(m_run, mx);
    const float alpha = __builtin_amdgcn_exp2f(m_run - m_new);
    m_run = m_new;
    float rsum = 0.f;
#pragma unroll
    for (int T = 0; T < 2; ++T)
#pragma unroll
      for (int e = 0; e < 16; ++e) { float pv = __builtin_amdgcn_exp2f(s[T][e] - m_new); s[T][e] = pv; rsum += pv; }
    l_run = l_run * alpha + rsum;
#pragma unroll
    for (int i = 0; i < 2; ++i)
#pragma unroll
      for (int e = 0; e < 16; ++e) o[i][e] *= alpha;
#pragma unroll
    for (int T = 0; T < 2; ++T)
#pragma unroll
      for (int ss = 0; ss < 2; ++ss) {
        uint4 pk;
        pk.x = pack2(s[T][8 * ss + 0], s[T][8 * ss + 1]);
        pk.y = pack2(s[T][8 * ss + 2], s[T][8 * ss + 3]);
        pk.z = pack2(s[T][8 * ss + 4], s[T][8 * ss + 5]);
        pk.w = pack2(s[T][8 * ss + 6], s[T][8 * ss + 7]);
        bf16x8 pf = __builtin_bit_cast(bf16x8, pk);
#pragma unroll
        for (int dt = 0; dt < 2; ++dt) {
          const u16* vp = Vb + (dt * 32 + r) * VLD + 32 * T + 16 * ss + 4 * hh;
          uint2 lo = *(const uint2*)vp;
          uint2 hi = *(const uint2*)(vp + 8);
          uint4 vv = make_uint4(lo.x, lo.y, hi.x, hi.y);
          o[dt] = MFMA32(__builtin_bit_cast(bf16x8, vv), pf, o[dt]);
        }
      }
  };
  KVRegs RA, RB;
  prefetch(RA, 0);
  if (1 < nt_all) prefetch(RB, 1);
  lds_write(RA, 0);
  __syncthreads();
  for (int kt = 0; kt < nt_all; kt += 2) {
    if (kt + 2 < nt_all) prefetch(RA, kt + 2);
    if (kt < my_nt) compute(kt);
    if (kt + 1 < nt_all) lds_write(RB, 1);
    __syncthreads();
    if (kt + 1 < nt_all) {
      if (kt + 3 < nt_all) prefetch(RB, kt + 3);
      if (kt + 1 < my_nt) compute(kt + 1);
      if (kt + 2 < nt_all) lds_write(RA, 0);
      __syncthreads();
    }
  }
  if (my_nt > 0) {
    float l = l_run + __shfl_xor(l_run, 32);
    float inv = 1.0f / l;
    int qr = wave * 32 + r;
    if (qr < q_valid) {
#pragma unroll
      for (int dt = 0; dt < 2; ++dt)
#pragma unroll
        for (int g = 0; g < 4; ++g) {
          uint2 st;
          st.x = pack2(o[dt][4 * g + 0] * inv, o[dt][4 * g + 1] * inv);
          st.y = pack2(o[dt][4 * g + 2] * inv, o[dt][4 * g + 3] * inv);
          *(uint2*)(O + (size_t)qr * 512 + dt * 32 + 8 * g + 4 * hh) = st;
        }
    }
  }
  __syncthreads();
}

__device__ __forceinline__ void phase_mixers(const Params& p, char* smem) {
  char* ws = p.ws;
#ifndef SUBM
#define SUBM 3
#endif
  if (SUBM & 1) {
    for (int it = blockIdx.x; it < 2048; it += gridDim.x) scan_item(p, false, it >> 7, (it >> 4) & 7, it & 15, (float*)smem);
    for (int it = blockIdx.x; it < 256; it += gridDim.x) scan_item(p, true, it >> 7, (it >> 4) & 7, it & 15, (float*)smem);
  }
  if (SUBM & 2) {
    int* cnt = (int*)(ws + OFF_CNT);
    int* sitem = (int*)(smem + 81472);
    const u16* Q = (const u16*)(ws + OFF_Q);
    u16* Oat = (u16*)((char*)p.out + SC_OAT);
    constexpr int NITEMS = 128 + 1024 + 16;
    for (;;) {
      if (threadIdx.x == 0) *sitem = atomicAdd(cnt, 1);
      __syncthreads();
      const int it = *sitem;
      __syncthreads();
      if (it >= NITEMS) break;
      size_t q0, k0; int h, ldv, fv, nlo, nhi, qv;
      const u16 *kn, *kr, *vt;
      if (it < 128) {
        int b = it >> 3; h = it & 7;
        q0 = (size_t)TP + b * 16; k0 = (size_t)b * LKS;
        kn = (const u16*)(ws + OFF_R6); kr = (const u16*)(ws + OFF_KRS); vt = (const u16*)(ws + OFF_VTS);
        ldv = LDVS; fv = 64; nlo = LKS; nhi = LKS; qv = 16;
      } else {
        kn = (const u16*)(ws + OFF_KNP); kr = (const u16*)(ws + OFF_KRP); vt = (const u16*)(ws + OFF_VTP);
        ldv = LDVP; fv = 16;
        if (it < 1152) {
          int j = it - 128;
          int qb = 63 - (j >> 4), b = (j >> 3) & 1; h = j & 7;
          k0 = (size_t)b * LP; q0 = k0 + 16 + 128 * qb;
          nlo = 16 + 64 * (2 * qb + 1); nhi = 16 + 64 * (2 * qb + 2); qv = 128;
        } else {
          int j = it - 1152;
          int b = j >> 3; h = j & 7;
          k0 = (size_t)b * LP; q0 = k0;
          nlo = 16; nhi = 16; qv = 16;
        }
      }
      attn_item(Q + q0 * 768 + h * 96, MT - (int)q0, kn + k0 * 512 + h * 64, kr + k0 * 32, vt + (size_t)(h * 64) * ldv + k0, ldv, fv,
                nlo, nhi, Oat + q0 * 512 + h * 64, qv, (u16*)smem);
    }
  }
}

__device__ __forceinline__ void phase_postmix(const Params& p) {
  char* ws = p.ws;
  const int lane = threadIdx.x & 63, wave = threadIdx.x >> 6;
  const u16* Prkv = (const u16*)(ws + OFF_PRKV);
  const u16* Aa = (const u16*)((const char*)p.out + SC_AA);
  const u16* Yb = (const u16*)((const char*)p.out + SC_YB);
  const u16* Oat = (const u16*)((const char*)p.out + SC_OAT);
  const u16* Gg = (const u16*)(ws + OFF_GG);
  u16* Ocat = (u16*)(ws + OFF_OCAT);
  const float* mu_shift = p.in[10];
  const float* k_a = p.in[17]; const float* r_k = p.in[18]; const float* gn_g = p.in[19]; const float* gn_b = p.in[20];
  const float* og = p.in[25];
  for (int m2 = blockIdx.x * 4 + wave; m2 < M2; m2 += gridDim.x * 4) {
    const bool prompt = m2 < 16384;
    const int m = prompt ? ((m2 >> 13) * LP + 16 + (m2 & 8191)) : (TP + m2 - 16384);
    const bool first = (!prompt) && (((m2 - 16384) & 15) == 0);
    const float* ss = p.in[5] + (size_t)(prompt ? 0 : ((m2 - 16384) >> 4)) * CR;
    const u16* row = Prkv + (size_t)m * NRKV;
#pragma unroll 4
    for (int h = 0; h < 8; ++h) {
      int col = h * 64 + lane;
      float y = bf2f(Yb[(size_t)m * 512 + col]);
      float mu = wave_sum(y) * (1.0f / 64.0f);
      float d = y - mu;
      float var = wave_sum(d * d) * (1.0f / 64.0f);
      float yn = d * rsqrtf(var + 64e-5f) * gn_g[col] + gn_b[col];
      const float r = bf2f(row[col]), k = bf2f(row[512 + col]), v = bf2f(row[1024 + col]);
      float a = bf2f(Aa[(size_t)m * 512 + col]);
      float kt = k * (1.0f + (a - 1.0f) * k_a[col]);
      float bs = wave_sum(r * kt * r_k[col]);
      float o = (yn + bs * v) * bf2f(Gg[(size_t)m * 512 + col]);
      Ocat[(size_t)m2 * 1024 + col] = f2bf(o);
    }
    float v[8]; float sq = 0.f;
#pragma unroll
    for (int i = 0; i < 8; ++i) { v[i] = bf2f(Oat[(size_t)m * 512 + lane + 64 * i]); sq += v[i] * v[i]; }
    float rs = rsqrtf(wave_sum(sq) * (1.0f / 512.0f) + 1e-6f);
#pragma unroll
    for (int i = 0; i < 8; ++i) Ocat[(size_t)m2 * 1024 + 512 + lane + 64 * i] = f2bf(v[i] * rs * og[lane + 64 * i]);
    if (!prompt) {
      const float* xs = p.in[1] + (size_t)(m2 - 16384) * 1024;
      const float* st = (const float*)(ws + OFF_STATS) + 2 * (size_t)m;
      const float xmu = st[0], xrs = st[1];
#pragma unroll
      for (int i = 0; i < 4; ++i) {
        const int c = lane * 4 + 256 * i;
        const float4 xv = *(const float4*)(xs + c), gg = *(const float4*)(p.in[7] + c), b4 = *(const float4*)(p.in[8] + c);
        float4 o;
        o.x = ALPHA * ((xv.x - xmu) * xrs * gg.x + b4.x); o.y = ALPHA * ((xv.y - xmu) * xrs * gg.y + b4.y);
        o.z = ALPHA * ((xv.z - xmu) * xrs * gg.z + b4.z); o.w = ALPHA * ((xv.w - xmu) * xrs * gg.w + b4.w);
        *(float4*)(p.out + (size_t)m2 * 1024 + c) = o;
      }
    }
  }
}

__device__ __forceinline__ void phase_ln(const Params& p, const float* g, const float* b, u16* hb, float oscale) {
  const int lane = threadIdx.x & 63, wave = threadIdx.x >> 6;
  const int stride = gridDim.x * 4;
  for (int m2 = blockIdx.x * 4 + wave; m2 < M2; m2 += 2 * stride) {
    const int mB = m2 + stride;
    const bool hasB = mB < M2;
    float* rowA = p.out + (size_t)m2 * 1024;
    float* rowB = p.out + (size_t)(hasB ? mB : m2) * 1024;
    float4 va[4], vb[4];
#pragma unroll
    for (int i = 0; i < 4; ++i) { va[i] = *(const float4*)(rowA + lane * 4 + 256 * i); vb[i] = *(const float4*)(rowB + lane * 4 + 256 * i); }
    float sa = 0.f, sb = 0.f;
#pragma unroll
    for (int i = 0; i < 4; ++i) { sa += va[i].x + va[i].y + va[i].z + va[i].w; sb += vb[i].x + vb[i].y + vb[i].z + vb[i].w; }
    const float muA = wave_sum(sa) * (1.0f / 1024.0f), muB = wave_sum(sb) * (1.0f / 1024.0f);
    float qa = 0.f, qb = 0.f;
#pragma unroll
    for (int i = 0; i < 4; ++i) {
      float a0 = va[i].x - muA, a1 = va[i].y - muA, a2 = va[i].z - muA, a3 = va[i].w - muA;
      float b0 = vb[i].x - muB, b1 = vb[i].y - muB, b2 = vb[i].z - muB, b3 = vb[i].w - muB;
      qa += a0 * a0 + a1 * a1 + a2 * a2 + a3 * a3;
      qb += b0 * b0 + b1 * b1 + b2 * b2 + b3 * b3;
    }
    const float rsA = rsqrtf(wave_sum(qa) * (1.0f / 1024.0f) + 1e-5f), rsB = rsqrtf(wave_sum(qb) * (1.0f / 1024.0f) + 1e-5f);
#pragma unroll
    for (int i = 0; i < 4; ++i) {
      int c = lane * 4 + 256 * i;
      float4 gg = *(const float4*)(g + c), b4 = *(const float4*)(b + c);
      float4 o;
      o.x = (va[i].x - muA) * rsA * gg.x + b4.x; o.y = (va[i].y - muA) * rsA * gg.y + b4.y;
      o.z = (va[i].z - muA) * rsA * gg.z + b4.z; o.w = (va[i].w - muA) * rsA * gg.w + b4.w;
      *(float4*)(rowA + c) = make_float4(o.x * oscale, o.y * oscale, o.z * oscale, o.w * oscale);
      if (hb) { uint2 t; t.x = pack2(o.x, o.y); t.y = pack2(o.z, o.w); *(uint2*)(hb + (size_t)m2 * 1024 + c) = t; }
      if (hasB) {
        o.x = (vb[i].x - muB) * rsB * gg.x + b4.x; o.y = (vb[i].y - muB) * rsB * gg.y + b4.y;
        o.z = (vb[i].z - muB) * rsB * gg.z + b4.z; o.w = (vb[i].w - muB) * rsB * gg.w + b4.w;
        *(float4*)(rowB + c) = make_float4(o.x * oscale, o.y * oscale, o.z * oscale, o.w * oscale);
        if (hb) { uint2 t; t.x = pack2(o.x, o.y); t.y = pack2(o.z, o.w); *(uint2*)(hb + (size_t)mB * 1024 + c) = t; }
      }
    }
  }
}

DI void fast_barrier(unsigned* word) {
  asm volatile("s_waitcnt vmcnt(0) lgkmcnt(0)" ::: "memory");
  __syncthreads();
  if (threadIdx.x == 0) {
    __builtin_amdgcn_fence(__ATOMIC_RELEASE, "agent");
    asm volatile("s_waitcnt vmcnt(0)" ::: "memory");
    __hip_atomic_fetch_add(word, 1u, __ATOMIC_RELAXED, __HIP_MEMORY_SCOPE_AGENT);
    const unsigned target = gridDim.x;
    unsigned spins = 0;
    while (__hip_atomic_load(word, __ATOMIC_RELAXED, __HIP_MEMORY_SCOPE_AGENT) < target) {
      __builtin_amdgcn_s_sleep(2);
      if (++spins > (1u << 24)) break;
    }
    __builtin_amdgcn_fence(__ATOMIC_ACQUIRE, "agent");
    asm volatile("s_waitcnt vmcnt(0)" ::: "memory");
  }
  __syncthreads();
}

#define XB_TMO      128
#define XB_XCNT(j)  (256  + 64 * (j))
#define XB_XSUB(j)  (1280 + 64 * (j))
#define XB_XGEN(j)  (2304 + 64 * (j))
#define XB_TOP      3328
#define XB_TOPGEN   3392
#define XB_SPIN_CAP (1u << 20)
DI unsigned xb_ld(unsigned* p) { return __hip_atomic_load(p, __ATOMIC_RELAXED, __HIP_MEMORY_SCOPE_AGENT); }
DI unsigned xb_add(unsigned* p, unsigned v) { return __hip_atomic_fetch_add(p, v, __ATOMIC_RELAXED, __HIP_MEMORY_SCOPE_AGENT); }
DI unsigned xb_xcc_id() { return (unsigned)__builtin_amdgcn_s_getreg((3 << 11) | 20) & 0xFu; }
#define XB_SPIN(cond, bar) do { unsigned _sp = 0; while (cond) { __builtin_amdgcn_s_sleep(1); \
    if ((++_sp & 255u) == 0u) { if (xb_ld(&(bar)[XB_TMO])) break; if (_sp > XB_SPIN_CAP) { atomicAdd(&(bar)[XB_TMO], 1u); break; } } } } while (0)
struct XcdBarrier { unsigned* bar; unsigned x; volatile unsigned* st; };
DI XcdBarrier xcd_barrier_post(unsigned* bar, volatile unsigned* st) {
  XcdBarrier b; b.bar = bar; b.x = xb_xcc_id(); b.st = st;
  if (threadIdx.x == 0) (void)xb_add(&bar[XB_XCNT(b.x)], 1u);
  return b;
}
DI void xcd_barrier_complete(unsigned* bar, unsigned x, unsigned& nloc, unsigned& nx) {
  const unsigned G = gridDim.x;
  unsigned sum, cnt, mine, sp = 0u;
  for (;;) {
    sum = 0u; cnt = 0u; mine = 0u;
#pragma unroll
    for (unsigned j = 0; j < 16; ++j) { const unsigned c = xb_ld(&bar[XB_XCNT(j)]); sum += c; cnt += (c > 0u) ? 1u : 0u; mine = (j == x) ? c : mine; }
    if (sum == G) break;
    __builtin_amdgcn_s_sleep(1);
    if ((++sp & 255u) == 0u) { if (xb_ld(&bar[XB_TMO])) break; if (sp > XB_SPIN_CAP) { atomicAdd(&bar[XB_TMO], 1u); break; } }
  }
  nloc = mine > 0u ? mine : 1u; nx = cnt > 0u ? cnt : 1u;
}
DI void xcd_barrier(const XcdBarrier& b) {
  asm volatile("s_waitcnt vmcnt(0)" ::: "memory");
  __syncthreads();
  if (threadIdx.x == 0) {
    unsigned* bar = b.bar;
    __builtin_amdgcn_s_waitcnt(0);
    unsigned nloc = b.st[0], nx = b.st[1];
    if (nloc == 0u) { xcd_barrier_complete(bar, b.x, nloc, nx); b.st[0] = nloc; b.st[1] = nx; }
    const unsigned old = xb_add(&bar[XB_XSUB(b.x)], 1u);
    const unsigned gen = old / nloc;
    if (old + 1u == (gen + 1u) * nloc) {
      __builtin_amdgcn_fence(__ATOMIC_RELEASE, "agent");
      asm volatile("s_waitcnt vmcnt(0)" ::: "memory");
      const unsigned og = xb_add(&bar[XB_TOP], 1u);
      const unsigned tg = og / nx;
      if (og + 1u == (tg + 1u) * nx) xb_add(&bar[XB_TOPGEN], 1u);
      else XB_SPIN(xb_ld(&bar[XB_TOPGEN]) == tg, bar);
      __builtin_amdgcn_fence(__ATOMIC_ACQUIRE, "agent");
      xb_add(&bar[XB_XGEN(b.x)], 1u);
      asm volatile("s_waitcnt vmcnt(0)" ::: "memory");
    } else {
      XB_SPIN(xb_ld(&bar[XB_XGEN(b.x)]) == gen, bar);
      __builtin_amdgcn_fence(__ATOMIC_ACQUIRE, "agent");
      asm volatile("s_waitcnt vmcnt(0)" ::: "memory");
    }
  }
  __syncthreads();
}

__global__ void __launch_bounds__(256, 2) fwd_megakernel(Params p) {
  __shared__ __attribute__((aligned(16))) char smem[SMEM_BYTES];
  cg::grid_group grid = cg::this_grid();
  char* ws = p.ws;
  unsigned* bar = (unsigned*)(ws + OFF_CNT);

#ifndef PHM
#define PHM 0xFFFF
#endif
  volatile unsigned* xst = (volatile unsigned*)(smem + 81472 + 16);
  if (threadIdx.x == 0) { xst[0] = 0u; xst[1] = 0u; }
  __syncthreads();
  const XcdBarrier xbar = xcd_barrier_post((unsigned*)(ws + OFF_XB), xst);
  if (PHM & 1) phase_prep(p, smem);
  if (p.ws == nullptr) grid.sync();
  xcd_barrier(xbar);
  if (PHM & 2) {
    EpiInproj e{(u16*)(ws + OFF_PRKV), (u16*)(ws + OFF_R6), p.out};
    constexpr int TM = (MT + 127) / 128, TN = (CIN + 127) / 128;
    gemm_phase((const u16*)(ws + OFF_R2), 1024, (const u16*)(ws + OFF_WIN), 1024, MT, CIN, 1024, TM * TN,
               [](int t, int& m0, int& n0) { m0 = (t / TN) * 128; n0 = (t % TN) * 128; }, e, (u16*)smem);
  }
  xcd_barrier(xbar);
  if (PHM & 4) phase_postproj(p);
  {
    ShiftSave sv;
    shift_save(p, sv);
    xcd_barrier(xbar);
    shift_apply(p, sv);
  }
  if (PHM & 8) phase_gemms3(p, (u16*)smem);
  xcd_barrier(xbar);
  if (PHM & 16) phase_mixers(p, smem);
  xcd_barrier(xbar);
  if (PHM & 32) phase_postmix(p);
  xcd_barrier(xbar);
  if (PHM & 64) {
    EpiOut e{p.in[0], p.in[1], (const float*)(ws + OFF_STATS), p.in[7], p.in[8], p.out};
    const int G = gridDim.x, NT = 130 * 8;
    const int full = (NT / G) * G, left = NT - full;
    int pieces = left > 0 ? G / left : 0; pieces = pieces > 16 ? 16 : pieces;
    const bool split = left > 0 && pieces >= 2 && (16 % pieces) == 0 && full >= 128 * 8;
    gemm_phase((const u16*)(ws + OFF_OCAT), 1024, (const u16*)(ws + OFF_WOUT), 1024, M2, 1024, 1024, split ? full : NT,
               [](int t, int& m0, int& n0) { m0 = (t >> 3) * 128; n0 = (t & 7) * 128; }, e, (u16*)smem);
    if (split && (int)blockIdx.x < left * pieces) {
      EpiDownAtomic ea{p.out};
      const int t = full + (int)blockIdx.x / pieces, pc = (int)blockIdx.x % pieces, klen = 1024 / pieces;
      gemm_tile((const u16*)(ws + OFF_OCAT), 1024, (const u16*)(ws + OFF_WOUT), 1024, M2, 1024, klen, (t >> 3) * 128, (t & 7) * 128, ea,
                (u16*)smem, pc * klen);
    }
  }
  xcd_barrier(xbar);
  if (PHM & 128) phase_ln(p, p.in[27], p.in[28], (u16*)(ws + OFF_H1B), ALPHA);
  xcd_barrier(xbar);
  if (PHM & 256) {
    EpiUp e{(u16*)(ws + OFF_ACT)};
    gemm_phase((const u16*)(ws + OFF_H1B), 1024, (const u16*)(ws + OFF_WUP), 1024, M2, 4096, 1024, 130 * 32,
               [](int t, int& m0, int& n0) { m0 = (t >> 5) * 128; n0 = (t & 31) * 128; }, e, (u16*)smem);
  }
  xcd_barrier(xbar);
  if (PHM & 512) {
    EpiDown e{p.out};
    const int G = gridDim.x, NT = 130 * 8;
    const int full = (NT / G) * G, left = NT - full;
    const int pieces = left > 0 ? G / left : 0;
    const bool split = left > 0 && pieces >= 2 && pieces <= 64 && (64 % pieces) == 0 && pieces * left == G;
    for (int t = blockIdx.x; t < (split ? full : NT); t += gridDim.x)
      gemm_tile((const u16*)(ws + OFF_ACT), 4096, (const u16*)(ws + OFF_WDOWN), 4096, M2, 1024, 4096, (t >> 3) * 128, (t & 7) * 128, e,
                (u16*)smem);
    if (split) {
      EpiDownAtomic ea{p.out};
      const int t = full + (int)blockIdx.x / pieces, pc = (int)blockIdx.x % pieces, klen = 4096 / pieces;
      gemm_tile((const u16*)(ws + OFF_ACT), 4096, (const u16*)(ws + OFF_WDOWN), 4096, M2, 1024, klen, (t >> 3) * 128, (t & 7) * 128, ea,
                (u16*)smem, pc * klen);
    }
  }
  xcd_barrier(xbar);
  if (PHM & 1024) phase_ln(p, p.in[31], p.in[32], nullptr, 1.0f);
}

extern "C" void kernel_launch(void* const* d_in, const int* in_sizes, int n_in, void* d_out, int out_size, void* d_ws,
                              size_t ws_size, hipStream_t stream) {
  static int grid_blocks = 0;
  if (!grid_blocks) {
    int dev = 0, cus = 0, per_cu = 0;
    hipGetDevice(&dev);
    hipDeviceGetAttribute(&cus, hipDeviceAttributeMultiprocessorCount, dev);
    hipOccupancyMaxActiveBlocksPerMultiprocessor(&per_cu, (const void*)fwd_megakernel, 256, 0);
    if (per_cu > 2) per_cu = 2;
    if (per_cu < 1) per_cu = 1;
    grid_blocks = cus * per_cu;
  }
  Params p{};
  for (int i = 0; i < 33; ++i) p.in[i] = (const float*)d_in[i];
  p.out = (float*)d_out;
  p.ws = (char*)d_ws;
  hipMemsetAsync((char*)d_ws + OFF_CNT, 0, 8192, stream);
  hipMemsetAsync((char*)d_ws + OFF_XB, 0, 16384, stream);
  void* args[] = {&p};
  hipError_t e = hipLaunchCooperativeKernel((const void*)fwd_megakernel, dim3(grid_blocks), dim3(256), args, 0, stream);
  if (e != hipSuccess) fprintf(stderr, "cooperative launch failed: %s (grid %d)\n", hipGetErrorString(e), grid_blocks);
}
```
